# Optimizing an MI355X kernel written in HIP

```python
import math
import jax, jax.numpy as jnp
from jax import lax
import numpy as np

D_MODEL = 1024
BATCH = 4
SEQ = 4096
DEPTH = 4

HEAD_DIM = 64
ROPE_THETA = 10000.0
Q_BLOCK = 128
NORM_EPS = 1e-6
NEG_INF = -1e30
BIG = 1e30

NSA_HEADS = 8
NSA_GROUPS = 2
NSA_HPG = NSA_HEADS // NSA_GROUPS
CMP_BLOCK = 32
CMP_STRIDE = 16
SEL_BLOCK = 64
SEL_TOPK = 16
WINDOW = 512
NSA_Q_CHUNK = 64

DIFF_HEADS = 4
DIFF_VDIM = 2 * HEAD_DIM

SB_HEADS = D_MODEL // HEAD_DIM
SB_WIDTH = SB_HEADS * HEAD_DIM

FFN_HIDDEN = -(-(8 * D_MODEL) // (3 * 256)) * 256

NSA_Q_W = NSA_HEADS * HEAD_DIM
NSA_KV_W = NSA_GROUPS * HEAD_DIM
NSA_GATE_W = 3 * NSA_HEADS
DIFF_QK_W = DIFF_HEADS * 2 * HEAD_DIM
DIFF_V_W = DIFF_HEADS * DIFF_VDIM
EVEN_SIZES = (NSA_Q_W, NSA_KV_W, NSA_KV_W, NSA_KV_W, NSA_KV_W, NSA_KV_W, NSA_KV_W,
              NSA_GATE_W, DIFF_QK_W, DIFF_QK_W, DIFF_V_W)
EVEN_IN = sum(EVEN_SIZES)
EVEN_OUT = NSA_HEADS * HEAD_DIM + DIFF_HEADS * DIFF_VDIM

N_EVEN = (DEPTH + 1) // 2
N_ODD = DEPTH // 2

kernel_name = "nsa_diff_stickbreaking_hybrid"


def rmsnorm(x, g):
    xf = x.astype(jnp.float32)
    y = xf * lax.rsqrt(jnp.mean(xf * xf, axis=-1, keepdims=True) + NORM_EPS)
    return (y * g.astype(jnp.float32)).astype(x.dtype)


def rope_tables(seq, dim):
    inv = 1.0 / (ROPE_THETA ** (jnp.arange(0, dim, 2, dtype=jnp.float32) / dim))
    ang = jnp.arange(seq, dtype=jnp.float32)[:, None] * inv[None, :]
    return jnp.cos(ang), jnp.sin(ang)


def apply_rope(x, cos, sin):
    x1, x2 = jnp.split(x, 2, axis=-1)
    c = cos[None, :, None, :].astype(x.dtype)
    s = sin[None, :, None, :].astype(x.dtype)
    return jnp.concatenate([x1 * c - x2 * s, x1 * s + x2 * c], axis=-1)


def masked_softmax(s, mask):
    s = jnp.where(mask, s.astype(jnp.float32), NEG_INF)
    return jnp.where(mask, jax.nn.softmax(s, axis=-1), 0.0)


def nsa_mixer(q, kc, vc, ks, vs, kw, vw, gate_logits,
              cmp_pos_k, cmp_w_k, cmp_pos_v, cmp_w_v, cos, sin):
    B, S = q.shape[0], q.shape[1]
    G, HPG, D = NSA_GROUPS, NSA_HPG, HEAD_DIM
    scale = D ** -0.5
    q = apply_rope(q, cos, sin)
    kc, ks, kw = apply_rope(kc, cos, sin), apply_rope(ks, cos, sin), apply_rope(kw, cos, sin)
    qg = q.reshape(B, S, G, HPG, D).transpose(0, 2, 3, 1, 4)
    kc, vc, ks, vs, kw, vw = [a.transpose(0, 2, 1, 3) for a in (kc, vc, ks, vs, kw, vw)]
    pos = jnp.arange(S)

    n_cmp = (S - CMP_BLOCK) // CMP_STRIDE + 1
    cmp_start = jnp.arange(n_cmp) * CMP_STRIDE
    cmp_idx = cmp_start[:, None] + jnp.arange(CMP_BLOCK)[None, :]

    def compress(a, p, w):
        blocks = a[:, :, cmp_idx] + p
        return blocks.reshape(B, G, n_cmp, CMP_BLOCK * D) @ w

    k_cmp = compress(kc, cmp_pos_k, cmp_w_k)
    v_cmp = compress(vc, cmp_pos_v, cmp_w_v)
    s_cmp = jnp.einsum('bghsd,bgnd->bghsn', qg, k_cmp) * scale
    cmp_mask = (cmp_start + CMP_BLOCK - 1)[None, :] <= pos[:, None]
    p_cmp = masked_softmax(s_cmp, cmp_mask)
    o_cmp = jnp.einsum('bghsn,bgnd->bghsd', p_cmp.astype(v_cmp.dtype), v_cmp)

    n_slc = S // SEL_BLOCK
    sel_start = jnp.arange(n_slc) * SEL_BLOCK
    cmp_to_sel = ((cmp_start[:, None] < sel_start[None, :] + SEL_BLOCK) &
                  (cmp_start[:, None] + CMP_BLOCK > sel_start[None, :])).astype(jnp.float32)
    imp = jnp.einsum('bghsn,nj->bgsj', p_cmp, cmp_to_sel)
    qblk = pos // SEL_BLOCK
    jb = jnp.arange(n_slc)
    forced = (jb[None, :] == 0) | (jb[None, :] == qblk[:, None]) | (jb[None, :] == qblk[:, None] - 1)
    future = jb[None, :] > qblk[:, None]
    imp = jnp.where(forced, BIG, jnp.where(future, -BIG, imp))
    n_top = min(SEL_TOPK, n_slc)
    top_val, top_idx = lax.top_k(imp, n_top)
    top_ok = top_val >= 0.0

    Qc = NSA_Q_CHUNK
    nc = S // Qc
    ks_blk = ks.reshape(B, G, n_slc, SEL_BLOCK, D)
    vs_blk = vs.reshape(B, G, n_slc, SEL_BLOCK, D)
    kw_pad = jnp.pad(kw, ((0, 0), (0, 0), (WINDOW, 0), (0, 0)))
    vw_pad = jnp.pad(vw, ((0, 0), (0, 0), (WINDOW, 0), (0, 0)))
    q_ch = qg.reshape(B, G, HPG, nc, Qc, D).transpose(3, 0, 1, 2, 4, 5)
    idx_ch = top_idx.reshape(B, G, nc, Qc, n_top).transpose(2, 0, 1, 3, 4)
    ok_ch = top_ok.reshape(B, G, nc, Qc, n_top).transpose(2, 0, 1, 3, 4)
    bi = jnp.arange(B)[:, None, None, None]
    gi = jnp.arange(G)[None, :, None, None]
    offs = jnp.arange(SEL_BLOCK)
    n_sel_keys = n_top * SEL_BLOCK

    def chunk(args):
        c, q_c, idx_c, ok_c = args
        t = c * Qc + jnp.arange(Qc)
        k_sel = ks_blk[bi, gi, idx_c].reshape(B, G, Qc, n_sel_keys, D)
        v_sel = vs_blk[bi, gi, idx_c].reshape(B, G, Qc, n_sel_keys, D)
        kpos = idx_c[..., None] * SEL_BLOCK + offs
        m_sel = (ok_c[..., None] & (kpos <= t[None, None, :, None, None])).reshape(B, G, Qc, n_sel_keys)
        s_sel = jnp.einsum('bghqd,bgqnd->bghqn', q_c, k_sel) * scale
        p_sel = masked_softmax(s_sel, m_sel[:, :, None])
        o_sel = jnp.einsum('bghqn,bgqnd->bghqd', p_sel.astype(v_sel.dtype), v_sel)
        k_w = lax.dynamic_slice_in_dim(kw_pad, c * Qc, Qc + WINDOW, axis=2)
        v_w = lax.dynamic_slice_in_dim(vw_pad, c * Qc, Qc + WINDOW, axis=2)
        wpos = c * Qc - WINDOW + jnp.arange(Qc + WINDOW)
        m_w = ((wpos[None, :] <= t[:, None]) & (wpos[None, :] > t[:, None] - WINDOW)
               & (wpos[None, :] >= 0))
        s_w = jnp.einsum('bghqd,bgkd->bghqk', q_c, k_w) * scale
        p_w = masked_softmax(s_w, m_w)
        o_w = jnp.einsum('bghqk,bgkd->bghqd', p_w.astype(v_w.dtype), v_w)
        return o_sel, o_w

    o_sel, o_win = lax.map(chunk, (jnp.arange(nc), q_ch, idx_ch, ok_ch))
    o_sel = o_sel.transpose(1, 0, 4, 2, 3, 5).reshape(B, S, NSA_HEADS, D)
    o_win = o_win.transpose(1, 0, 4, 2, 3, 5).reshape(B, S, NSA_HEADS, D)
    o_cmp = o_cmp.transpose(0, 3, 1, 2, 4).reshape(B, S, NSA_HEADS, D)

    g = jax.nn.sigmoid(gate_logits)
    o = g[..., 0:1] * o_cmp + g[..., 1:2] * o_sel + g[..., 2:3] * o_win
    return o.reshape(B, S, NSA_HEADS * D)


def diff_mixer(q, k, v, lq1, lk1, lq2, lk2, subln, lam_init, cos, sin):
    B, S = q.shape[0], q.shape[1]
    H, D = DIFF_HEADS, HEAD_DIM
    scale = D ** -0.5
    heads = lambda a: a.transpose(0, 2, 1, 3)
    q1 = heads(apply_rope(q[:, :, :, 0], cos, sin))
    q2 = heads(apply_rope(q[:, :, :, 1], cos, sin))
    k1 = heads(apply_rope(k[:, :, :, 0], cos, sin))
    k2 = heads(apply_rope(k[:, :, :, 1], cos, sin))
    vh = heads(v)
    lam = (jnp.exp(jnp.sum(lq1.astype(jnp.float32) * lk1.astype(jnp.float32)))
           - jnp.exp(jnp.sum(lq2.astype(jnp.float32) * lk2.astype(jnp.float32))) + lam_init)
    nb = S // Q_BLOCK
    q1b = q1.reshape(B, H, nb, Q_BLOCK, D).transpose(2, 0, 1, 3, 4)
    q2b = q2.reshape(B, H, nb, Q_BLOCK, D).transpose(2, 0, 1, 3, 4)
    kpos = jnp.arange(S)

    def blk(args):
        i, a1, a2 = args
        t = i * Q_BLOCK + jnp.arange(Q_BLOCK)
        m = kpos[None, :] <= t[:, None]
        p1 = masked_softmax(jnp.einsum('bhqd,bhkd->bhqk', a1, k1) * scale, m)
        p2 = masked_softmax(jnp.einsum('bhqd,bhkd->bhqk', a2, k2) * scale, m)
        attn = p1 - lam * p2
        return jnp.einsum('bhqk,bhkd->bhqd', attn.astype(vh.dtype), vh)

    o = lax.map(blk, (jnp.arange(nb), q1b, q2b))
    o = o.transpose(1, 0, 3, 2, 4).reshape(B, S, H, DIFF_VDIM)
    o = rmsnorm(o, subln) * (1.0 - lam_init)
    return o.reshape(B, S, H * DIFF_VDIM)


def even_mixer(h, w_in, w_out, cmp_pos_k, cmp_w_k, cmp_pos_v, cmp_w_v,
               lq1, lk1, lq2, lk2, subln, lam_init, cos, sin):
    B, S, _ = h.shape
    splits = np.cumsum(EVEN_SIZES)[:-1].tolist()
    parts = jnp.split(h @ w_in, splits, axis=-1)
    nq, kc, vc, ks, vs, kw, vw, gl, dq, dk, dv = parts
    kvs = [a.reshape(B, S, NSA_GROUPS, HEAD_DIM) for a in (kc, vc, ks, vs, kw, vw)]
    o_nsa = nsa_mixer(nq.reshape(B, S, NSA_HEADS, HEAD_DIM), *kvs,
                      gl.reshape(B, S, NSA_HEADS, 3),
                      cmp_pos_k, cmp_w_k, cmp_pos_v, cmp_w_v, cos, sin)
    o_diff = diff_mixer(dq.reshape(B, S, DIFF_HEADS, 2, HEAD_DIM),
                        dk.reshape(B, S, DIFF_HEADS, 2, HEAD_DIM),
                        dv.reshape(B, S, DIFF_HEADS, DIFF_VDIM),
                        lq1, lk1, lq2, lk2, subln, lam_init, cos, sin)
    return jnp.concatenate([o_nsa, o_diff], axis=-1) @ w_out


def sb_mixer(h, w_in, w_out):
    B, S, _ = h.shape
    scale = HEAD_DIM ** -0.5
    q, k, v = jnp.split(h @ w_in, 3, axis=-1)
    heads = lambda a: a.reshape(B, S, SB_HEADS, HEAD_DIM).transpose(0, 2, 1, 3)
    q, k, v = heads(q), heads(k), heads(v)
    nb = S // Q_BLOCK
    qb = q.reshape(B, SB_HEADS, nb, Q_BLOCK, HEAD_DIM).transpose(2, 0, 1, 3, 4)
    kpos = jnp.arange(S)

    def blk(args):
        i, q_c = args
        t = i * Q_BLOCK + jnp.arange(Q_BLOCK)
        strict = kpos[None, :] < t[:, None]
        z = jnp.einsum('bhqd,bhkd->bhqk', q_c, k).astype(jnp.float32) * scale
        log_rest = jnp.where(strict, jax.nn.log_sigmoid(-z), 0.0)
        suffix = lax.cumsum(log_rest, axis=3, reverse=True) - log_rest
        a = jnp.where(strict, jnp.exp(jax.nn.log_sigmoid(z) + suffix), 0.0)
        return jnp.einsum('bhqk,bhkd->bhqd', a.astype(v.dtype), v)

    o = lax.map(blk, (jnp.arange(nb), qb))
    o = o.transpose(1, 0, 3, 2, 4).reshape(B, S, SB_WIDTH)
    return o @ w_out


def swiglu(h, w_gate, w_up, w_down):
    return (jax.nn.silu(h @ w_gate) * (h @ w_up)) @ w_down


def _nrm(key, shape, scale):
    return jax.random.normal(key, shape, jnp.float32) * scale


def setup_inputs(seed: int = 0) -> dict:
    key = jax.random.key(seed)
    ks = jax.random.split(key, 24)
    d = D_MODEL
    return {
        "x": _nrm(ks[0], (BATCH, SEQ, d), 1.0),
        "norm_mix": 1.0 + _nrm(ks[1], (DEPTH, d), 0.02),
        "norm_ffn": 1.0 + _nrm(ks[2], (DEPTH, d), 0.02),
        "norm_final": 1.0 + _nrm(ks[3], (d,), 0.02),
        "even_w_in": _nrm(ks[4], (N_EVEN, d, EVEN_IN), d ** -0.5),
        "even_w_out": _nrm(ks[5], (N_EVEN, EVEN_OUT, d), EVEN_OUT ** -0.5),
        "cmp_pos_k": _nrm(ks[6], (N_EVEN, CMP_BLOCK, HEAD_DIM), 0.3),
        "cmp_w_k": _nrm(ks[7], (N_EVEN, CMP_BLOCK * HEAD_DIM, HEAD_DIM), (CMP_BLOCK * HEAD_DIM) ** -0.5),
        "cmp_pos_v": _nrm(ks[8], (N_EVEN, CMP_BLOCK, HEAD_DIM), 0.3),
        "cmp_w_v": _nrm(ks[9], (N_EVEN, CMP_BLOCK * HEAD_DIM, HEAD_DIM), (CMP_BLOCK * HEAD_DIM) ** -0.5),
        "diff_lq1": _nrm(ks[10], (N_EVEN, HEAD_DIM), 0.1),
        "diff_lk1": _nrm(ks[11], (N_EVEN, HEAD_DIM), 0.1),
        "diff_lq2": _nrm(ks[12], (N_EVEN, HEAD_DIM), 0.1),
        "diff_lk2": _nrm(ks[13], (N_EVEN, HEAD_DIM), 0.1),
        "diff_subln": 1.0 + _nrm(ks[14], (N_EVEN, DIFF_VDIM), 0.02),
        "odd_w_in": _nrm(ks[15], (N_ODD, d, 3 * SB_WIDTH), d ** -0.5),
        "odd_w_out": _nrm(ks[16], (N_ODD, SB_WIDTH, d), SB_WIDTH ** -0.5),
        "ffn_w_gate": _nrm(ks[17], (DEPTH, d, FFN_HIDDEN), d ** -0.5),
        "ffn_w_up": _nrm(ks[18], (DEPTH, d, FFN_HIDDEN), d ** -0.5),
        "ffn_w_down": _nrm(ks[19], (DEPTH, FFN_HIDDEN, d), FFN_HIDDEN ** -0.5),
    }


def reference(x, norm_mix, norm_ffn, norm_final, even_w_in, even_w_out,
              cmp_pos_k, cmp_w_k, cmp_pos_v, cmp_w_v,
              diff_lq1, diff_lk1, diff_lq2, diff_lk2, diff_subln,
              odd_w_in, odd_w_out, ffn_w_gate, ffn_w_up, ffn_w_down):
    S = x.shape[1]
    cos, sin = rope_tables(S, HEAD_DIM)
    for layer in range(DEPTH):
        h = rmsnorm(x, norm_mix[layer])
        if layer % 2 == 0:
            e = layer // 2
            lam_init = 0.8 - 0.6 * math.exp(-0.3 * layer)
            y = even_mixer(h, even_w_in[e], even_w_out[e],
                           cmp_pos_k[e], cmp_w_k[e], cmp_pos_v[e], cmp_w_v[e],
                           diff_lq1[e], diff_lk1[e], diff_lq2[e], diff_lk2[e], diff_subln[e],
                           lam_init, cos, sin)
        else:
            o = layer // 2
            y = sb_mixer(h, odd_w_in[o], odd_w_out[o])
        x = x + y
        h = rmsnorm(x, norm_ffn[layer])
        x = x + swiglu(h, ffn_w_gate[layer], ffn_w_up[layer], ffn_w_down[layer])
    return rmsnorm(x, norm_final)
```

```cpp
#include <hip/hip_runtime.h>
#include <hip/hip_cooperative_groups.h>
#include <cstdio>
#include <cstring>
namespace cg = cooperative_groups;

#ifndef SB_EARLY
#define SB_EARLY 1
#endif
#ifndef PROBE_MODE
#define PROBE_MODE 0
#endif
#ifndef REPEAT_MASK
#define REPEAT_MASK 0ull
#endif

#define DI __device__ __forceinline__
typedef unsigned short bf16_t;
typedef unsigned long long u64;
typedef short bf16x8 __attribute__((ext_vector_type(8)));
typedef short bf16x4 __attribute__((ext_vector_type(4)));
typedef float f32x16 __attribute__((ext_vector_type(16)));
typedef float f32x4 __attribute__((ext_vector_type(4)));
typedef float f32x2 __attribute__((ext_vector_type(2)));
typedef unsigned u32x4 __attribute__((ext_vector_type(4)));
typedef unsigned u32x2 __attribute__((ext_vector_type(2)));
typedef __bf16 bf2_t __attribute__((ext_vector_type(2)));

DI unsigned pack2(float a, float b) { bf2_t v = __builtin_convertvector((f32x2){a, b}, bf2_t); return __builtin_bit_cast(unsigned, v); }
DI bf16_t tobf(float a) { return (bf16_t)(pack2(a, 0.f) & 0xffffu); }
#define MFMA(a, b, c) __builtin_amdgcn_mfma_f32_32x32x16_bf16((a), (b), (c), 0, 0, 0)
DI int crow(int i, int h) { return (i & 3) + 8 * (i >> 2) + 4 * h; }
DI float shx32(float v) { return __shfl_xor(v, 32); }
DI int otid() { int t = threadIdx.x; asm volatile("" : "+v"(t)); return t; }
template <class T> DI T* launder(T* q) { asm volatile("" : "+s"(q)); return q; }

constexpr int S = 4096, M = 16384, DM = 1024, FH = 2816, EN = 2944;
constexpr int LDX = 1088, LDF = 2880, SP = 4224;
constexpr float L2E = 1.4426950408889634f;
constexpr float NEG = -1e30f;

constexpr size_t MiB = 1048576;
constexpr size_t OFF_CTRL = 0;
constexpr size_t OFF_COS = 4096;
constexpr size_t OFF_SIN = OFF_COS + 524288;
constexpr size_t OFF_CBIAS = OFF_SIN + 524288;
constexpr size_t OFF_CPART = OFF_CBIAS + 4096;
constexpr size_t OFF_BAR = OFF_CPART + 32768;
constexpr size_t OFF_CMPW = OFF_BAR + 16384;
constexpr size_t OFF_WEI = OFF_CMPW + 2097152;
constexpr size_t OFF_WEO = OFF_WEI + (size_t)2 * EN * LDX * 2;
constexpr size_t OFF_WOI = OFF_WEO + (size_t)2 * 1024 * LDX * 2;
constexpr size_t OFF_WOO = OFF_WOI + (size_t)2 * 3072 * LDX * 2;
constexpr size_t OFF_WGU = OFF_WOO + (size_t)2 * 1024 * LDX * 2;
constexpr size_t OFF_WDN = OFF_WGU + (size_t)5632 * LDX * 2;
constexpr size_t OFF_SSQ = OFF_WDN + (size_t)1024 * LDF * 2;
constexpr size_t OFF_HB = OFF_SSQ + 1048576;
constexpr size_t OFF_XB = OFF_HB + (size_t)M * LDX * 2;
constexpr size_t OFF_BIG = OFF_XB + (size_t)M * LDX * 2;
static_assert(OFF_BIG + 98 * MiB < 250 * MiB, "workspace budget");

struct Params {
  const float *x, *norm_mix, *norm_ffn, *norm_final, *even_w_in, *even_w_out, *cmp_pos_k, *cmp_w_k, *cmp_pos_v, *cmp_w_v;
  const float *lq1, *lk1, *lq2, *lk2, *subln, *odd_w_in, *odd_w_out, *w_gate, *w_up, *w_down;
  float* out;
  unsigned char* ws;
};

struct EvenBufs { bf16_t *QN, *KC, *VC, *KS, *VST, *KW, *VWT, *DQ, *DK, *DVT, *KCMP, *VCMPT; float* gate; };
DI EvenBufs even_bufs(unsigned char* big) {
  constexpr size_t VSTB = (size_t)8 * 64 * SP * 2, DVTB = (size_t)16 * 128 * SP * 2;
  EvenBufs e; unsigned char* q = big;
  e.QN = (bf16_t*)q; q += 16 * MiB; e.KC = (bf16_t*)q; q += 4 * MiB; e.VC = (bf16_t*)q; q += 4 * MiB; e.KS = (bf16_t*)q; q += 4 * MiB;
  e.VST = (bf16_t*)q; q += VSTB; e.KW = (bf16_t*)q; q += 4 * MiB; e.VWT = (bf16_t*)q; q += VSTB; e.DQ = (bf16_t*)q; q += 16 * MiB;
  e.DK = (bf16_t*)q; q += 16 * MiB; e.DVT = (bf16_t*)q; q += DVTB; e.gate = (float*)q; q += 1572864;
  e.KCMP = (bf16_t*)q; q += 262144; e.VCMPT = (bf16_t*)q;
  return e;
}

template <int NV> struct TR_ { u32x4 v[NV]; };
typedef const __attribute__((address_space(1))) u32x4* gvec_t;
DI u32x4 gload16(const bf16_t* p) { return *(gvec_t)(unsigned long long)p; }
template <int NV> DI void tload(TR_<NV>& t, const bf16_t* g, size_t ld, int tid) {
#pragma unroll
  for (int i = 0; i < NV; ++i) t.v[i] = gload16(g + (size_t)((tid >> 3) + 32 * i) * ld + (tid & 7) * 8);
  __builtin_amdgcn_sched_barrier(0);
}
template <int NV> DI void tstore72(const TR_<NV>& t, bf16_t* s, int tid) {
#pragma unroll
  for (int i = 0; i < NV; ++i) *(u32x4*)(s + ((tid >> 3) + 32 * i) * 72 + (tid & 7) * 8) = t.v[i];
}
template <int NV> DI void tstore68(const TR_<NV>& t, bf16_t* s, int tid) {
#pragma unroll
  for (int i = 0; i < NV; ++i) {
    bf16_t* d = s + ((tid >> 3) + 32 * i) * 68 + (tid & 7) * 8;
    *(u32x2*)d = (u32x2){t.v[i].x, t.v[i].y};
    *(u32x2*)(d + 4) = (u32x2){t.v[i].z, t.v[i].w};
  }
}

constexpr int LDT = 40;
struct GRegs { u32x4 a[4], b[2]; };
DI void g_issue(GRegs& g, const bf16_t* Ag, size_t lda, const bf16_t* Bg, size_t ldb, unsigned offA, unsigned offB, int kt) {
#pragma unroll
  for (int i = 0; i < 4; ++i) g.a[i] = *(gvec_t)((unsigned long long)(Ag + (size_t)(64 * i) * lda + kt * 32) + offA);
#pragma unroll
  for (int i = 0; i < 2; ++i) g.b[i] = *(gvec_t)((unsigned long long)(Bg + (size_t)(64 * i) * ldb + kt * 32) + offB);
}
DI void g_write(const GRegs& g, bf16_t* cA, bf16_t* cB, int tid) {
  const int row = tid >> 2, pc = (tid & 3) ^ ((tid >> 4) & 3);
#pragma unroll
  for (int i = 0; i < 4; ++i) *(u32x4*)(cA + (row + 64 * i) * 32 + pc * 8) = g.a[i];
#pragma unroll
  for (int i = 0; i < 2; ++i) *(u32x4*)(cB + (row + 64 * i) * 32 + pc * 8) = g.b[i];
}
constexpr int STG_A = 8192, STG = 12288;
DI void dma_issue(const bf16_t* Ag, size_t lda, const bf16_t* Bg, size_t ldb, int kt, bf16_t* stage, int wid, int lane) {
  const int rl = lane >> 2, c = (lane & 3) ^ ((lane >> 4) & 3);
#pragma unroll
  for (int i = 0; i < 4; ++i) {
    const int j = wid + 4 * i;
    __builtin_amdgcn_global_load_lds((const unsigned*)(Ag + (size_t)(16 * j + rl) * lda + kt * 32 + c * 8), (unsigned*)(stage + j * 512), 16, 0, 0);
  }
#pragma unroll
  for (int i = 0; i < 2; ++i) {
    const int j = wid + 4 * i;
    __builtin_amdgcn_global_load_lds((const unsigned*)(Bg + (size_t)(16 * j + rl) * ldb + kt * 32 + c * 8), (unsigned*)(stage + STG_A + j * 512), 16, 0, 0);
  }
}
template <bool VT>
DI void g_compute(const bf16_t* cA, const bf16_t* cB, f32x16 (&acc)[4][2], int wm, int wn, int r, int h) {
  bf16x8 af[2][4], bfr[2][2];
#pragma unroll
  for (int s = 0; s < 2; ++s) {
#pragma unroll
    for (int ni = 0; ni < 2; ++ni) bfr[s][ni] = *(const bf16x8*)(cB + (wn * 64 + ni * 32 + r) * 32 + (((2 * s + h) ^ (r >> 2)) & 3) * 8);
#pragma unroll
    for (int mi = 0; mi < 4; ++mi) af[s][mi] = *(const bf16x8*)(cA + (wm * 128 + mi * 32 + r) * 32 + (((2 * s + h) ^ (r >> 2)) & 3) * 8);
  }
  __builtin_amdgcn_sched_barrier(0);
#pragma unroll
  for (int s = 0; s < 2; ++s)
#pragma unroll
    for (int mi = 0; mi < 4; ++mi)
#pragma unroll
      for (int ni = 0; ni < 2; ++ni) {
        if (VT) acc[mi][ni] = MFMA(af[s][mi], bfr[s][ni], acc[mi][ni]);
        else acc[mi][ni] = MFMA(bfr[s][ni], af[s][mi], acc[mi][ni]);
      }
}
#define DSR(dst, addr, off) asm volatile("ds_read_b128 %0, %1 offset:" #off : "=&v"(dst) : "v"(addr))
template <bool VT>
DI void g_compute_asm(unsigned aA0, unsigned aA1, unsigned aB0, unsigned aB1, f32x16 (&acc)[4][2]) {
  bf16x8 a0[4], a1[4], b0[2], b1[2];
  DSR(b0[0], aB0, 0); DSR(b0[1], aB0, 2048);
  DSR(a0[0], aA0, 0); DSR(a0[1], aA0, 2048); DSR(a0[2], aA0, 4096); DSR(a0[3], aA0, 6144);
  DSR(b1[0], aB1, 0); DSR(b1[1], aB1, 2048);
  DSR(a1[0], aA1, 0); DSR(a1[1], aA1, 2048); DSR(a1[2], aA1, 4096); DSR(a1[3], aA1, 6144);
  asm volatile("s_waitcnt lgkmcnt(6)" : "+v"(b0[0]), "+v"(b0[1]), "+v"(a0[0]), "+v"(a0[1]), "+v"(a0[2]), "+v"(a0[3]));
#pragma unroll
  for (int mi = 0; mi < 4; ++mi)
#pragma unroll
    for (int ni = 0; ni < 2; ++ni) {
      if (VT) acc[mi][ni] = MFMA(a0[mi], b0[ni], acc[mi][ni]);
      else acc[mi][ni] = MFMA(b0[ni], a0[mi], acc[mi][ni]);
    }
  __builtin_amdgcn_sched_barrier(0);
  asm volatile("s_waitcnt lgkmcnt(0)" : "+v"(b1[0]), "+v"(b1[1]), "+v"(a1[0]), "+v"(a1[1]), "+v"(a1[2]), "+v"(a1[3]));
#pragma unroll
  for (int mi = 0; mi < 4; ++mi)
#pragma unroll
    for (int ni = 0; ni < 2; ++ni) {
      if (VT) acc[mi][ni] = MFMA(a1[mi], b1[ni], acc[mi][ni]);
      else acc[mi][ni] = MFMA(b1[ni], a1[mi], acc[mi][ni]);
    }
}
template <bool VT>
DI int gemm_kloop(const bf16_t* Ag, size_t lda, const bf16_t* Bg, size_t ldb, int nk, bf16_t* ring, f32x16 (&acc)[4][2], int tid, int wm, int wn,
                  int r, int h, int st0, bool pre, const bf16_t* AgN, const bf16_t* BgN) {
  const int wid = tid >> 6, lane = tid & 63;
  const unsigned base = (unsigned)(unsigned long long)ring;
  const int q = (r >> 2) & 3;
  const unsigned rA = base + (unsigned)(wm * 128 + r) * 64u, rB = base + (unsigned)STG_A * 2u + (unsigned)(wn * 64 + r) * 64u;
  const unsigned oA0 = rA + (unsigned)((h ^ q) & 3) * 16u, oA1 = rA + (unsigned)(((2 + h) ^ q) & 3) * 16u;
  const unsigned oB0 = rB + (unsigned)((h ^ q) & 3) * 16u, oB1 = rB + (unsigned)(((2 + h) ^ q) & 3) * 16u;
  int st = st0;
  if (!pre) {
    dma_issue(Ag, lda, Bg, ldb, 0, ring + st * STG, wid, lane);
    dma_issue(Ag, lda, Bg, ldb, 1, ring + (st == 2 ? 0 : st + 1) * STG, wid, lane);
  }
  for (int kt = 0; kt < nk - 1; ++kt) {
    asm volatile("s_waitcnt vmcnt(6)" ::: "memory");
    __builtin_amdgcn_s_barrier();
    if (kt + 2 < nk) dma_issue(Ag, lda, Bg, ldb, kt + 2, ring + (st == 0 ? 2 : st - 1) * STG, wid, lane);
    const unsigned so = (unsigned)st * (unsigned)(STG * 2);
    g_compute_asm<VT>(oA0 + so, oA1 + so, oB0 + so, oB1 + so, acc);
    st = st == 2 ? 0 : st + 1;
  }
  asm volatile("s_waitcnt vmcnt(0)" ::: "memory");
  __builtin_amdgcn_s_barrier();
  if (AgN) {
    const int s1 = st == 2 ? 0 : st + 1, s2 = s1 == 2 ? 0 : s1 + 1;
    dma_issue(AgN, lda, BgN, ldb, 0, ring + s1 * STG, wid, lane);
    dma_issue(AgN, lda, BgN, ldb, 1, ring + s2 * STG, wid, lane);
  }
  {
    const unsigned so = (unsigned)st * (unsigned)(STG * 2);
    g_compute_asm<VT>(oA0 + so, oA1 + so, oB0 + so, oB1 + so, acc);
  }
  asm volatile("s_waitcnt lgkmcnt(0)" ::: "memory");
  return st;
}
template <bool VT>
DI void gemm_kloop_simple(const bf16_t* Ag, size_t lda, const bf16_t* Bg, size_t ldb, int nk, bf16_t* sA, bf16_t* sB, f32x16 (&acc)[4][2], int tid, int wm,
                          int wn, int r, int h) {
  GRegs g0;
  const unsigned offA = (unsigned)(((tid >> 2) * lda + (tid & 3) * 8) * 2), offB = (unsigned)(((tid >> 2) * ldb + (tid & 3) * 8) * 2);
  g_issue(g0, Ag, lda, Bg, ldb, offA, offB, 0);
  for (int kt = 0; kt < nk; ++kt) {
    bf16_t* cA = sA + (kt & 1) * STG;
    bf16_t* cB = cA + STG_A;
    g_write(g0, cA, cB, tid);
    __syncthreads();
    if (kt + 1 < nk) g_issue(g0, Ag, lda, Bg, ldb, offA, offB, kt + 1);
    __builtin_amdgcn_sched_barrier(0);
    g_compute<VT>(cA, cB, acc, wm, wn, r, h);
  }
}
template <bool DEEP, class Epi>
DI int gemm_tile(const bf16_t* __restrict__ A, int lda, const bf16_t* __restrict__ Bt, int ldb, int K, const float* ssq, int tm, int tn, const Epi& epi,
                 unsigned char* smem, int pm, int st0 = 0, bool pre = false, int tmN = -1, int tnN = 0) {
  const int tid = otid();
  const int lane = tid & 63, wid = tid >> 6, r = lane & 31, h = lane >> 5, wm = wid >> 1, wn = wid & 1;
  bf16_t* sA = (bf16_t*)smem;
  bf16_t* sB = sA;
  float* sR = (float*)(smem + 73728);
  const int m0 = tm << 8, n0 = tn << 7;
  const bf16_t* Ag = A + (size_t)m0 * lda;
  const bf16_t* Bg = Bt + (size_t)n0 * ldb;
  if (ssq) {
    const f32x4* sp = (const f32x4*)(ssq + (size_t)(m0 + tid) * 16);
    const f32x4 a = sp[0], b = sp[1], c = sp[2], d = sp[3];
    const float tot = ((a.x + a.y) + (a.z + a.w)) + ((b.x + b.y) + (b.z + b.w)) + ((c.x + c.y) + (c.z + c.w)) + ((d.x + d.y) + (d.z + d.w));
    sR[tid] = rsqrtf(tot * (1.f / DM) + 1e-6f);
  }
  __syncthreads();
  f32x16 acc[4][2];
#pragma unroll
  for (int a = 0; a < 4; ++a)
#pragma unroll
    for (int b = 0; b < 2; ++b)
#pragma unroll
      for (int i = 0; i < 16; ++i) acc[a][b][i] = 0.f;
  const bool vt = epi.vtype(n0 + wn * 64);
  int st_last = 0;
  if (pm == 2) K >>= 1;
  if (DEEP) {
    const bf16_t* AgN = tmN >= 0 ? A + (size_t)(tmN << 8) * lda : nullptr;
    const bf16_t* BgN = Bt + (size_t)(tnN << 7) * ldb;
    if (vt) st_last = gemm_kloop<true>(Ag, lda, Bg, ldb, K >> 5, sA, acc, tid, wm, wn, r, h, st0, pre, AgN, BgN);
    else st_last = gemm_kloop<false>(Ag, lda, Bg, ldb, K >> 5, sA, acc, tid, wm, wn, r, h, st0, pre, AgN, BgN);
  } else {
    if (vt) gemm_kloop_simple<true>(Ag, lda, Bg, ldb, K >> 5, sA, sB, acc, tid, wm, wn, r, h);
    else gemm_kloop_simple<false>(Ag, lda, Bg, ldb, K >> 5, sA, sB, acc, tid, wm, wn, r, h);
  }
  if (Epi::STAGED) __syncthreads();
  float* stg = Epi::CHAIN ? (float*)(smem + st_last * (STG * 2) + wid * 6144) : (float*)smem + wid * 2176;
  if (pm == 0) epi(acc, vt, m0 + wm * 128, n0 + wn * 64, r, h, sR + wm * 128, stg);
  __syncthreads();
  return st_last;
}
template <class Epi>
DI void gemm_phase(const bf16_t* __restrict__ A, int lda, const bf16_t* __restrict__ Bt, int ldb, int Mr, int N, int K, const float* ssq, const Epi& epi,
                   unsigned char* smem, int pm = 0) {
  const int tid = otid();
  const int nM = Mr >> 8, nN = (N + 127) >> 7, ntiles = nM * nN;
  const int band = nM >> 3;
  int st0 = 0; bool pre = false;
  for (int t = blockIdx.x; t < ntiles; t += gridDim.x) {
    const int xcd = t & 7, j = t >> 3;
    const int grp = j / (8 * nN), jj = j % (8 * nN);
    const int tm = xcd * band + grp * 8 + (jj & 7), tn = jj >> 3;
    int tmN = -1, tnN = 0;
    const int tN = t + (int)gridDim.x;
    if (Epi::CHAIN && tN < ntiles) {
      const int xN = tN & 7, jN = tN >> 3, gN = jN / (8 * nN), jjN = jN % (8 * nN);
      tmN = xN * band + gN * 8 + (jjN & 7); tnN = jjN >> 3;
    }
    const int stl = gemm_tile<true>(A, lda, Bt, ldb, K, ssq, tm, tn, epi, smem, pm, st0, pre, tmN, tnN);
    pre = tmN >= 0;
    st0 = stl == 2 ? 0 : stl + 1;
  }
}

DI u32x2 pack4(float a, float b, float c, float d) { u32x2 w; w.x = pack2(a, b); w.y = pack2(c, d); return w; }
DI void flush_rows(const bf16_t* st, bf16_t* dst, int lane) {
#pragma unroll
  for (int j = 0; j < 4; ++j) {
    const int rr = j * 8 + (lane >> 3), cc = (lane & 7) * 8;
    *(u32x4*)(dst + rr * 64 + cc) = *(const u32x4*)(st + rr * 72 + cc);
  }
}
DI void flush_tr(const bf16_t* st, bf16_t* dst, int lane) {
#pragma unroll
  for (int j = 0; j < 4; ++j) {
    const int dd = j * 16 + (lane >> 2), cc = (lane & 3) * 8;
    *(u32x4*)(dst + (size_t)dd * SP + cc) = *(const u32x4*)(st + dd * 40 + cc);
  }
}
struct EpiEvenIn {
  static constexpr bool STAGED = true, CHAIN = true;
  EvenBufs eb; const float* cosT; const float* sinT;
  DI bool vtype(int col0) const { const int seg = col0 >> 6; return seg == 14 || seg == 15 || seg == 18 || seg == 19 || (seg >= 36 && seg < 44); }
  DI void rope(const f32x16 (&acc)[4][2], int row0, int r, int h, const float* sR, bf16_t* dst, int H, int hh, float scale, bf16_t* st) const {
    const int lane = h * 32 + r, b = row0 >> 12, sb = row0 & 4095;
#pragma unroll
    for (int mi = 0; mi < 4; ++mi) {
      const int s = sb + mi * 32 + r;
      const float rv = sR[mi * 32 + r] * scale;
#pragma unroll
      for (int g = 0; g < 4; ++g) {
        const int d0 = 8 * g + 4 * h;
        const f32x4 c = *(const f32x4*)(cosT + s * 32 + d0), sn = *(const f32x4*)(sinT + s * 32 + d0);
        float o1[4], o2[4];
#pragma unroll
        for (int q = 0; q < 4; ++q) {
          const float x1 = acc[mi][0][4 * g + q] * rv, x2 = acc[mi][1][4 * g + q] * rv;
          o1[q] = x1 * c[q] - x2 * sn[q]; o2[q] = x1 * sn[q] + x2 * c[q];
        }
        *(u32x2*)(st + r * 72 + d0) = pack4(o1[0], o1[1], o1[2], o1[3]);
        *(u32x2*)(st + r * 72 + 32 + d0) = pack4(o2[0], o2[1], o2[2], o2[3]);
      }
      flush_rows(st, dst + ((size_t)(b * H + hh) * S + sb + mi * 32) * 64, lane);
    }
  }
  DI void rowmajor(const f32x16 (&acc)[4][2], int row0, int r, int h, const float* sR, bf16_t* dst, int H, int hh, float scale, bf16_t* st) const {
    const int lane = h * 32 + r, b = row0 >> 12, sb = row0 & 4095;
#pragma unroll
    for (int mi = 0; mi < 4; ++mi) {
      const float rv = sR[mi * 32 + r] * scale;
#pragma unroll
      for (int ni = 0; ni < 2; ++ni)
#pragma unroll
        for (int g = 0; g < 4; ++g)
          *(u32x2*)(st + r * 72 + ni * 32 + 8 * g + 4 * h) = pack4(acc[mi][ni][4 * g] * rv, acc[mi][ni][4 * g + 1] * rv, acc[mi][ni][4 * g + 2] * rv, acc[mi][ni][4 * g + 3] * rv);
      flush_rows(st, dst + ((size_t)(b * H + hh) * S + sb + mi * 32) * 64, lane);
    }
  }
  DI void transposed(const f32x16 (&acc)[4][2], int row0, int r, int h, const float* sR, bf16_t* dst, int H, int hh, bf16_t* st) const {
    const int lane = h * 32 + r, b = row0 >> 12, sb = row0 & 4095;
#pragma unroll
    for (int mi = 0; mi < 4; ++mi) {
#pragma unroll
      for (int g = 0; g < 4; ++g) {
        const f32x4 rv = *(const f32x4*)(sR + mi * 32 + 8 * g + 4 * h);
#pragma unroll
        for (int ni = 0; ni < 2; ++ni)
          *(u32x2*)(st + (ni * 32 + r) * 40 + 8 * g + 4 * h) =
              pack4(acc[mi][ni][4 * g] * rv.x, acc[mi][ni][4 * g + 1] * rv.y, acc[mi][ni][4 * g + 2] * rv.z, acc[mi][ni][4 * g + 3] * rv.w);
      }
      flush_tr(st, dst + (size_t)(b * H + hh) * 64 * SP + sb + mi * 32, lane);
    }
  }
  DI void operator()(const f32x16 (&acc)[4][2], bool vt, int row0, int col0, int r, int h, const float* sR, float* stage) const {
    const int seg = col0 >> 6;
    bf16_t* st = (bf16_t*)stage;
    if (seg < 8) rope(acc, row0, r, h, sR, eb.QN, 8, seg, 0.125f, st);
    else if (seg < 10) rope(acc, row0, r, h, sR, eb.KC, 2, seg - 8, 1.f, st);
    else if (seg < 12) rowmajor(acc, row0, r, h, sR, eb.VC, 2, seg - 10, 1.f, st);
    else if (seg < 14) rope(acc, row0, r, h, sR, eb.KS, 2, seg - 12, 1.f, st);
    else if (seg < 16) transposed(acc, row0, r, h, sR, eb.VST, 2, seg - 14, st);
    else if (seg < 18) rope(acc, row0, r, h, sR, eb.KW, 2, seg - 16, 1.f, st);
    else if (seg < 20) transposed(acc, row0, r, h, sR, eb.VWT, 2, seg - 18, st);
    else if (seg < 28) rope(acc, row0, r, h, sR, eb.DQ, 8, seg - 20, 0.125f, st);
    else if (seg < 36) rope(acc, row0, r, h, sR, eb.DK, 8, seg - 28, 1.f, st);
    else if (seg < 44) transposed(acc, row0, r, h, sR, eb.DVT, 8, seg - 36, st);
    else if (seg == 44) {
#pragma unroll
      for (int mi = 0; mi < 4; ++mi) {
        const int row = row0 + mi * 32 + r;
        const float rv = sR[mi * 32 + r];
#pragma unroll
        for (int g = 0; g < 3; ++g) {
          f32x4 o;
#pragma unroll
          for (int q = 0; q < 4; ++q) o[q] = 1.f / (1.f + __expf(-acc[mi][0][4 * g + q] * rv));
          *(f32x4*)(eb.gate + (size_t)row * 24 + 8 * g + 4 * h) = o;
        }
      }
    }
  }
};

struct EpiOddIn {
  static constexpr bool STAGED = true, CHAIN = true;
  bf16_t *Q, *K, *VT;
  DI bool vtype(int col0) const { return col0 >= 2048; }
  DI void operator()(const f32x16 (&acc)[4][2], bool vt, int row0, int col0, int r, int h, const float* sR, float* stage) const {
    const int seg = col0 >> 6, lane = h * 32 + r, b = row0 >> 12, sb = row0 & 4095;
    bf16_t* st = (bf16_t*)stage;
    if (seg < 32) {
      bf16_t* dst = seg < 16 ? Q : K; const int hh = seg & 15; const float sc = seg < 16 ? 0.125f : 1.f;
#pragma unroll
      for (int mi = 0; mi < 4; ++mi) {
        const float rv = sR[mi * 32 + r] * sc;
#pragma unroll
        for (int ni = 0; ni < 2; ++ni)
#pragma unroll
          for (int g = 0; g < 4; ++g)
            *(u32x2*)(st + r * 72 + ni * 32 + 8 * g + 4 * h) = pack4(acc[mi][ni][4 * g] * rv, acc[mi][ni][4 * g + 1] * rv, acc[mi][ni][4 * g + 2] * rv, acc[mi][ni][4 * g + 3] * rv);
        flush_rows(st, dst + ((size_t)(b * 16 + hh) * S + sb + mi * 32) * 64, lane);
      }
    } else {
      const int hh = seg - 32;
#pragma unroll
      for (int mi = 0; mi < 4; ++mi) {
#pragma unroll
        for (int g = 0; g < 4; ++g) {
          const f32x4 rv = *(const f32x4*)(sR + mi * 32 + 8 * g + 4 * h);
#pragma unroll
          for (int ni = 0; ni < 2; ++ni)
            *(u32x2*)(st + (ni * 32 + r) * 40 + 8 * g + 4 * h) =
                pack4(acc[mi][ni][4 * g] * rv.x, acc[mi][ni][4 * g + 1] * rv.y, acc[mi][ni][4 * g + 2] * rv.z, acc[mi][ni][4 * g + 3] * rv.w);
        }
        flush_tr(st, VT + (size_t)(b * 16 + hh) * 64 * SP + sb + mi * 32, lane);
      }
    }
  }
};

struct EpiResid {
  static constexpr bool STAGED = true, CHAIN = false;
  const float* rin; float* out; bf16_t* xb; float* ssq;
  DI bool vtype(int) const { return false; }
  DI void operator()(const f32x16 (&acc)[4][2], bool vt, int row0, int col0, int r, int h, const float* sR, float* stage) const {
    const int lane = h * 32 + r, lr = lane >> 4, lc = (lane & 15) * 4;
#pragma unroll
    for (int mi = 0; mi < 4; ++mi) {
#pragma unroll
      for (int ni = 0; ni < 2; ++ni)
#pragma unroll
        for (int g = 0; g < 4; ++g)
          *(f32x4*)(stage + r * 68 + ni * 32 + 8 * g + 4 * h) = (f32x4){acc[mi][ni][4 * g], acc[mi][ni][4 * g + 1], acc[mi][ni][4 * g + 2], acc[mi][ni][4 * g + 3]};
#pragma unroll
      for (int j = 0; j < 8; ++j) {
        const int rr = j * 4 + lr;
        f32x4 v = *(const f32x4*)(stage + rr * 68 + lc);
        const size_t row = row0 + mi * 32 + rr, idx = row * DM + col0 + lc;
        const f32x4 xin = *(const f32x4*)(rin + idx);
        v += xin;
        *(f32x4*)(out + idx) = v;
        *(u32x2*)(xb + row * LDX + col0 + lc) = pack4(v.x, v.y, v.z, v.w);
        float ss = (v.x * v.x + v.y * v.y) + (v.z * v.z + v.w * v.w);
        ss += __shfl_xor(ss, 1); ss += __shfl_xor(ss, 2); ss += __shfl_xor(ss, 4); ss += __shfl_xor(ss, 8);
        if ((lane & 15) == 0) ssq[row * 16 + (col0 >> 6)] = ss;
      }
    }
  }
};

struct EpiSwiGLU {
  static constexpr bool STAGED = true, CHAIN = true;
  bf16_t* act;
  DI bool vtype(int) const { return false; }
  DI void operator()(const f32x16 (&acc)[4][2], bool vt, int row0, int col0, int r, int h, const float* sR, float* stage) const {
    bf16_t* st = (bf16_t*)stage;
    const int lane = h * 32 + r;
#pragma unroll
    for (int mi = 0; mi < 4; ++mi) {
      const float rv = sR[mi * 32 + r];
#pragma unroll
      for (int g = 0; g < 4; ++g) {
        float o[4];
#pragma unroll
        for (int q = 0; q < 4; ++q) {
          const float gt = acc[mi][0][4 * g + q] * rv, up = acc[mi][1][4 * g + q] * rv;
          o[q] = gt * __builtin_amdgcn_rcpf(1.f + __expf(-gt)) * up;
        }
        *(u32x2*)(st + r * 40 + 8 * g + 4 * h) = pack4(o[0], o[1], o[2], o[3]);
      }
#pragma unroll
      for (int j = 0; j < 2; ++j) {
        const int rr = j * 16 + (lane >> 2), cc = (lane & 3) * 8;
        const u32x4 v = *(const u32x4*)(st + rr * 40 + cc);
        *(u32x4*)(act + (size_t)(row0 + mi * 32 + rr) * LDF + (col0 >> 1) + cc) = v;
      }
    }
  }
};

struct EpiCompress {
  static constexpr bool STAGED = false, CHAIN = false;
  bf16_t* dst; const float* sBias; int tr;
  DI bool vtype(int) const { return tr != 0; }
  DI void operator()(const f32x16 (&acc)[4][2], bool vt, int row0, int col0, int r, int h, const float*, float*) const {
    if (col0 != 0) return;
#pragma unroll
    for (int mi = 0; mi < 4; ++mi) {
      if (tr) {
#pragma unroll
        for (int g = 0; g < 4; ++g) {
          const int R = row0 + mi * 32 + 8 * g + 4 * h, bg = R >> 8, n = R & 255;
#pragma unroll
          for (int ni = 0; ni < 2; ++ni) {
            const float bv = sBias[ni * 32 + r];
            float v[4];
#pragma unroll
            for (int q = 0; q < 4; ++q) v[q] = (n + q == 255) ? 0.f : acc[mi][ni][4 * g + q] + bv;
            *(u32x2*)(dst + ((size_t)bg * 64 + ni * 32 + r) * 256 + n) = pack4(v[0], v[1], v[2], v[3]);
          }
        }
      } else {
        const int R = row0 + mi * 32 + r, bg = R >> 8, n = R & 255;
#pragma unroll
        for (int ni = 0; ni < 2; ++ni)
#pragma unroll
          for (int g = 0; g < 4; ++g) {
            const int d0 = ni * 32 + 8 * g + 4 * h;
            float v[4];
#pragma unroll
            for (int q = 0; q < 4; ++q) v[q] = (n == 255) ? 0.f : acc[mi][ni][4 * g + q] + sBias[d0 + q];
            *(u32x2*)(dst + ((size_t)bg * 256 + n) * 64 + d0) = pack4(v[0], v[1], v[2], v[3]);
          }
      }
    }
  }
};

DI void qk_tile(const bf16_t* sK, const bf16x8 (&qf)[4], f32x16 (&Sx)[2], int r, int h) {
#pragma unroll
  for (int mt = 0; mt < 2; ++mt) {
    f32x16 a;
#pragma unroll
    for (int i = 0; i < 16; ++i) a[i] = 0.f;
#pragma unroll
    for (int s = 0; s < 4; ++s) {
      const bf16x8 k = *(const bf16x8*)(sK + (mt * 32 + r) * 72 + s * 16 + h * 8);
      a = MFMA(k, qf[s], a);
    }
    Sx[mt] = a;
  }
}
template <int NDT> DI void pv_tile(const bf16_t* sV, const f32x16 (&P)[2], f32x16 (&O)[NDT], int r, int h) {
#pragma unroll
  for (int mt = 0; mt < 2; ++mt)
#pragma unroll
    for (int sp = 0; sp < 2; ++sp) {
      u32x4 pk;
      pk.x = pack2(P[mt][8 * sp + 0], P[mt][8 * sp + 1]); pk.y = pack2(P[mt][8 * sp + 2], P[mt][8 * sp + 3]);
      pk.z = pack2(P[mt][8 * sp + 4], P[mt][8 * sp + 5]); pk.w = pack2(P[mt][8 * sp + 6], P[mt][8 * sp + 7]);
      const bf16x8 pb = __builtin_bit_cast(bf16x8, pk);
#pragma unroll
      for (int dt = 0; dt < NDT; ++dt) {
        const bf16_t* vp = sV + (dt * 32 + r) * 68 + mt * 32 + sp * 16 + 4 * h;
        const bf16x4 lo = *(const bf16x4*)vp, hi = *(const bf16x4*)(vp + 8);
        const bf16x8 va = __builtin_shufflevector(lo, hi, 0, 1, 2, 3, 4, 5, 6, 7);
        O[dt] = MFMA(va, pb, O[dt]);
      }
      if (NDT > 2) __builtin_amdgcn_sched_barrier(0);
    }
}
template <bool MASKED>
DI float online_softmax_t(f32x16 (&Sx)[2], unsigned vb, float& m, float& l) {
  float mx = NEG;
#pragma unroll
  for (int mt = 0; mt < 2; ++mt)
#pragma unroll
    for (int i = 0; i < 16; ++i) {
      float s = Sx[mt][i];
      if (MASKED) { s = ((vb >> (mt * 16 + i)) & 1u) ? s : NEG; Sx[mt][i] = s; }
      mx = fmaxf(mx, s);
    }
  mx = fmaxf(mx, shx32(mx));
  const float mn = fmaxf(m, mx);
  const float alpha = __builtin_amdgcn_exp2f((m - mn) * L2E);
  const float mb = mn * L2E;
  f32x2 sum2 = {0.f, 0.f};
  const f32x2 l2e2 = {L2E, L2E}, mb2 = {mb, mb};
#pragma unroll
  for (int mt = 0; mt < 2; ++mt)
#pragma unroll
    for (int i = 0; i < 16; i += 2) {
      const f32x2 t = (f32x2){Sx[mt][i], Sx[mt][i + 1]} * l2e2 - mb2;
      f32x2 p = {__builtin_amdgcn_exp2f(t.x), __builtin_amdgcn_exp2f(t.y)};
      if (MASKED) { p.x = ((vb >> (mt * 16 + i)) & 1u) ? p.x : 0.f; p.y = ((vb >> (mt * 16 + i + 1)) & 1u) ? p.y : 0.f; }
      Sx[mt][i] = p.x; Sx[mt][i + 1] = p.y;
      sum2 += p;
    }
  l = l * alpha + (sum2.x + sum2.y);
  m = mn;
  return alpha;
}
DI float online_softmax(f32x16 (&Sx)[2], unsigned vb, bool masked, float& m, float& l) {
  float alpha;
  if (masked) alpha = online_softmax_t<true>(Sx, vb, m, l);
  else { __builtin_amdgcn_sched_barrier(0); alpha = online_softmax_t<false>(Sx, vb, m, l); __builtin_amdgcn_sched_barrier(0); }
  return alpha;
}
template <int NDT> DI void scale_o(f32x16 (&O)[NDT], float a) {
#pragma unroll
  for (int dt = 0; dt < NDT; ++dt)
#pragma unroll
    for (int i = 0; i < 16; ++i) O[dt][i] *= a;
}
template <int NDT> DI void zero_o(f32x16 (&O)[NDT]) {
#pragma unroll
  for (int dt = 0; dt < NDT; ++dt)
#pragma unroll
    for (int i = 0; i < 16; ++i) O[dt][i] = 0.f;
}
DI void load_q(bf16x8 (&qf)[4], const bf16_t* qrow, int h) {
#pragma unroll
  for (int s = 0; s < 4; ++s) qf[s] = *(const bf16x8*)(qrow + s * 16 + h * 8);
}

DI void diff_pass(const bf16_t* Qrow, const bf16_t* Kg, const bf16_t* VTg, int qt, int q0, int t, f32x16 (&O)[4], float& lsum,
                  bf16_t* sK, bf16_t* sV, int tid, int r, int h) {
  bf16x8 qf[4]; load_q(qf, Qrow, h);
  const int kt_hi = 2 * qt + 1, my_hi = (q0 + 31) >> 6;
  float m = NEG, l = 0.f;
  zero_o<4>(O);
  TR_<2> kr; TR_<4> vr;
  tload(kr, Kg, 64, tid); tload(vr, VTg, SP, tid);
  for (int kt = 0; kt <= kt_hi; ++kt) {
    __syncthreads();
    tstore72(kr, sK, tid); tstore68(vr, sV, tid);
    __syncthreads();
    if (kt < kt_hi) { tload(kr, Kg + (size_t)(kt + 1) * 64 * 64, 64, tid); tload(vr, VTg + (kt + 1) * 64, SP, tid); }
    if (kt <= my_hi) {
      f32x16 Sx[2];
      qk_tile(sK, qf, Sx, r, h);
      const bool masked = (kt * 64 + 63 > q0);
      unsigned vb = 0;
      if (masked) {
#pragma unroll
        for (int mt = 0; mt < 2; ++mt)
#pragma unroll
          for (int i = 0; i < 16; ++i) vb |= (unsigned)(kt * 64 + mt * 32 + crow(i, h) <= t) << (mt * 16 + i);
      }
      const float alpha = online_softmax(Sx, vb, masked, m, l);
      scale_o<4>(O, alpha);
      pv_tile<4>(sV, Sx, O, r, h);
    }
  }
  lsum = l + shx32(l);
}

DI void diff_item(const Params& p_, const EvenBufs& eb_, int e, int b, int hh, int qt, unsigned char* smem) {
  Params p = p_; p.ws = launder(p.ws); p.subln = launder(p.subln);
  const EvenBufs eb = even_bufs(p.ws + OFF_BIG);
  const int tid = otid(), lane = tid & 63, wid = tid >> 6, r = lane & 31, h = lane >> 5;
  bf16_t* sK = (bf16_t*)smem; bf16_t* sV = sK + 64 * 72;
  const int q0 = qt * 128 + wid * 32, t = q0 + r;
  const bf16_t* VTg = eb.DVT + (size_t)(b * 4 + hh) * 128 * SP;
  f32x16 O[4]; float l1, l2;
  diff_pass(eb.DQ + ((size_t)(b * 8 + hh * 2) * S + t) * 64, eb.DK + (size_t)(b * 8 + hh * 2) * S * 64, VTg, qt, q0, t, O, l1, sK, sV, tid, r, h);
  unsigned* o1s = (unsigned*)(smem + 40960) + tid;
  {
    const float inv = 1.f / l1;
#pragma unroll
    for (int dt = 0; dt < 4; ++dt)
#pragma unroll
      for (int i = 0; i < 8; ++i) o1s[(dt * 8 + i) * 256] = pack2(O[dt][2 * i] * inv, O[dt][2 * i + 1] * inv);
  }
  diff_pass(eb.DQ + ((size_t)(b * 8 + hh * 2 + 1) * S + t) * 64, eb.DK + (size_t)(b * 8 + hh * 2 + 1) * S * 64, VTg, qt, q0, t, O, l2, sK, sV, tid, r, h);
  int e2 = e; asm volatile("" : "+s"(e2));
  const float lam = ((const float*)(p.ws + OFF_CBIAS + 2048))[e2];
  const float lam_init = 0.8f - 0.6f * __expf(-0.3f * (float)(2 * e2));
  const float c2 = lam / l2;
  float ss = 0.f;
#pragma unroll
  for (int dt = 0; dt < 4; ++dt)
#pragma unroll
    for (int i = 0; i < 8; ++i) {
      const unsigned ov = o1s[(dt * 8 + i) * 256];
      const float a0 = __uint_as_float(ov << 16), a1 = __uint_as_float(ov & 0xffff0000u);
      const float v0 = a0 - c2 * O[dt][2 * i], v1 = a1 - c2 * O[dt][2 * i + 1];
      O[dt][2 * i] = v0; O[dt][2 * i + 1] = v1;
      ss += v0 * v0 + v1 * v1;
    }
  ss += shx32(ss);
  const float rinv = rsqrtf(ss * (1.f / 128.f) + 1e-6f) * (1.f - lam_init);
  const float* sub = p.subln + e * 128;
  bf16_t* orow = (bf16_t*)(p.ws + OFF_HB) + (size_t)(b * S + t) * LDX + 512 + hh * 128;
#pragma unroll
  for (int dt = 0; dt < 4; ++dt)
#pragma unroll
    for (int g = 0; g < 4; ++g) {
      __builtin_amdgcn_sched_barrier(0);
      const int d = dt * 32 + 8 * g + 4 * h;
      const f32x4 sg = *(const f32x4*)(sub + d);
      u32x2 w;
      w.x = pack2(O[dt][4 * g] * rinv * sg.x, O[dt][4 * g + 1] * rinv * sg.y);
      w.y = pack2(O[dt][4 * g + 2] * rinv * sg.z, O[dt][4 * g + 3] * rinv * sg.w);
      *(u32x2*)(orow + d) = w;
    }
}

DI void nsa_item(const Params& p_, const EvenBufs& eb_, int b, int g, int tt, unsigned char* smem) {
  Params p = p_; p.ws = launder(p.ws);
  const EvenBufs eb = even_bufs(p.ws + OFF_BIG);
  const int tid = otid(), lane = tid & 63, wid = tid >> 6, r = lane & 31, h = lane >> 5;
  bf16_t* sK = (bf16_t*)smem; bf16_t* sV = sK + 64 * 72;
  float* impW = (float*)(smem + 18432);
  u64* selm = (u64*)(smem + 18432 + 32768);
  const int t0 = tt * 32, t = t0 + r, head = g * 4 + wid, bg = b * 2 + g;
  bf16x8 qf[4]; load_q(qf, eb.QN + ((size_t)(b * 8 + head) * S + t) * 64, h);
  const float* gp = eb.gate + (size_t)(b * S + t) * 24 + head * 3;
  const float g0 = gp[0], g1 = gp[1], g2 = gp[2];
  f32x16 acc[2], O[2];

  const int nct = (t0 >> 10) + 1, nlim = (t - 31) >> 4;
  const bf16_t* Kc = eb.KCMP + (size_t)bg * 256 * 64;
  const bf16_t* VcT = eb.VCMPT + (size_t)bg * 64 * 256;
  float m = NEG, l = 0.f;
  for (int kt = 0; kt < nct; ++kt) {
    TR_<2> kr; tload(kr, Kc + kt * 64 * 64, 64, tid);
    __syncthreads();
    tstore72(kr, sK, tid);
    __syncthreads();
    f32x16 Sx[2]; qk_tile(sK, qf, Sx, r, h);
    unsigned vb = 0;
#pragma unroll
    for (int mt = 0; mt < 2; ++mt)
#pragma unroll
      for (int i = 0; i < 16; ++i) vb |= (unsigned)(kt * 64 + mt * 32 + crow(i, h) <= nlim) << (mt * 16 + i);
    online_softmax_t<true>(Sx, vb, m, l);
  }
  l += shx32(l);
  const float invl = l > 0.f ? 1.f / l : 0.f;
  const float mb = m * L2E;
  zero_o<2>(O);
  float carry_prev = 0.f;
  for (int kt = 0; kt < nct; ++kt) {
    TR_<2> kr, vr; tload(kr, Kc + kt * 64 * 64, 64, tid); tload(vr, VcT + kt * 64, 256, tid);
    __syncthreads();
    tstore72(kr, sK, tid); tstore68(vr, sV, tid);
    __syncthreads();
    f32x16 Sx[2]; qk_tile(sK, qf, Sx, r, h);
#pragma unroll
    for (int mt = 0; mt < 2; ++mt) {
#pragma unroll
      for (int i = 0; i < 16; ++i) {
        const bool ok = (kt * 64 + mt * 32 + crow(i, h)) <= nlim;
        const float pr = __builtin_amdgcn_exp2f(Sx[mt][i] * L2E - mb) * invl;
        Sx[mt][i] = ok ? pr : 0.f;
      }
      float x[4];
#pragma unroll
      for (int gg = 0; gg < 4; ++gg) x[gg] = shx32(Sx[mt][4 * gg + 3]);
#pragma unroll
      for (int gg = 0; gg < 4; ++gg) {
        const float prev = h ? x[gg] : (gg ? x[gg > 0 ? gg - 1 : 0] : carry_prev);
        const float val = Sx[mt][4 * gg] + Sx[mt][4 * gg + 1] + Sx[mt][4 * gg + 2] + Sx[mt][4 * gg + 3] + prev;
        impW[(wid * 32 + r) * 64 + kt * 16 + mt * 8 + 2 * gg + h] = val;
      }
      carry_prev = x[3];
    }
    pv_tile<2>(sV, Sx, O, r, h);
  }
#pragma unroll
  for (int dt = 0; dt < 2; ++dt)
#pragma unroll
    for (int i = 0; i < 16; ++i) acc[dt][i] = g0 * O[dt][i];
  __syncthreads();
  for (int q = 0; q < 8; ++q) {
    const int rr = wid * 8 + q, tq = t0 + rr, qb = tq >> 6;
    float v = 0.f;
    if (lane < nct * 16) v = impW[(0 * 32 + rr) * 64 + lane] + impW[(1 * 32 + rr) * 64 + lane] + impW[(2 * 32 + rr) * 64 + lane] + impW[(3 * 32 + rr) * 64 + lane];
    const bool forced = (lane == 0) || (lane == qb) || (lane == qb - 1);
    v = forced ? 1e30f : ((lane > qb) ? -1e30f : v);
    int rank = 0;
#pragma unroll
    for (int jj = 0; jj < 64; ++jj) {
      const float o = __builtin_bit_cast(float, __builtin_amdgcn_readlane(__builtin_bit_cast(int, v), jj));
      rank += ((o > v) || (o == v && jj < lane)) ? 1 : 0;
    }
    const bool sel = (rank < 16) && (v >= 0.f);
    const u64 mk = __ballot(sel);
    if (lane == 0) selm[rr] = mk;
  }
  __syncthreads();
  const u64 mysel = selm[r];
  u64 un;
  {
    unsigned lo = (unsigned)mysel, hi = (unsigned)(mysel >> 32);
#pragma unroll
    for (int o = 1; o < 32; o <<= 1) { lo |= (unsigned)__shfl_xor((int)lo, o); hi |= (unsigned)__shfl_xor((int)hi, o); }
    un = ((u64)hi << 32) | lo;
    un = ((u64)(unsigned)__builtin_amdgcn_readfirstlane((int)hi) << 32) | (unsigned)__builtin_amdgcn_readfirstlane((int)lo);
  }
  {
    const bf16_t* Kg = eb.KS + (size_t)bg * S * 64;
    const bf16_t* VTg = eb.VST + (size_t)bg * 64 * SP;
    m = NEG; l = 0.f; zero_o<2>(O);
    u64 rem = un;
    int j = __builtin_ctzll(rem); rem &= rem - 1;
    TR_<2> kr, vr; tload(kr, Kg + (size_t)j * 64 * 64, 64, tid); tload(vr, VTg + j * 64, SP, tid);
    while (true) {
      __syncthreads();
      tstore72(kr, sK, tid); tstore68(vr, sV, tid);
      __syncthreads();
      int jn = -1;
      if (rem) { jn = __builtin_ctzll(rem); rem &= rem - 1; tload(kr, Kg + (size_t)jn * 64 * 64, 64, tid); tload(vr, VTg + jn * 64, SP, tid); }
      f32x16 Sx[2]; qk_tile(sK, qf, Sx, r, h);
      const bool sb = (mysel >> j) & 1ull;
      unsigned vb = sb ? 0xffffffffu : 0u;
      bool masked = (__ballot(sb) != ~0ull);
      if (j == (t0 >> 6)) {
        masked = true; vb = 0;
#pragma unroll
        for (int mt = 0; mt < 2; ++mt)
#pragma unroll
          for (int i = 0; i < 16; ++i) vb |= (unsigned)(sb && (j * 64 + mt * 32 + crow(i, h) <= t)) << (mt * 16 + i);
      }
      if (!masked) vb = 0xffffffffu;
      const float alpha = online_softmax_t<true>(Sx, vb, m, l);
      scale_o<2>(O, alpha);
      pv_tile<2>(sV, Sx, O, r, h);
      if (jn < 0) break;
      j = jn;
    }
    l += shx32(l);
    const float c = g1 / l;
#pragma unroll
    for (int dt = 0; dt < 2; ++dt)
#pragma unroll
      for (int i = 0; i < 16; ++i) acc[dt][i] += c * O[dt][i];
  }
  {
    const bf16_t* Kg = eb.KW + (size_t)bg * S * 64;
    const bf16_t* VTg = eb.VWT + (size_t)bg * 64 * SP;
    m = NEG; l = 0.f; zero_o<2>(O);
    const int lo0 = t0 - 511;
    const int kt_lo = (lo0 > 0 ? lo0 : 0) >> 6, kt_hi = t0 >> 6;
    TR_<2> kr, vr; tload(kr, Kg + (size_t)kt_lo * 64 * 64, 64, tid); tload(vr, VTg + kt_lo * 64, SP, tid);
    for (int kt = kt_lo; kt <= kt_hi; ++kt) {
      __syncthreads();
      tstore72(kr, sK, tid); tstore68(vr, sV, tid);
      __syncthreads();
      if (kt < kt_hi) { tload(kr, Kg + (size_t)(kt + 1) * 64 * 64, 64, tid); tload(vr, VTg + (kt + 1) * 64, SP, tid); }
      f32x16 Sx[2]; qk_tile(sK, qf, Sx, r, h);
      const bool masked = !((kt * 64 + 63 <= t0) && (kt * 64 > t0 + 31 - 512));
      unsigned vb = 0;
      if (masked) {
#pragma unroll
        for (int mt = 0; mt < 2; ++mt)
#pragma unroll
          for (int i = 0; i < 16; ++i) {
            const int key = kt * 64 + mt * 32 + crow(i, h);
            vb |= (unsigned)((key <= t) && (key > t - 512)) << (mt * 16 + i);
          }
      }
      if (!masked) vb = 0xffffffffu;
      const float alpha = online_softmax_t<true>(Sx, vb, m, l);
      scale_o<2>(O, alpha);
      pv_tile<2>(sV, Sx, O, r, h);
    }
    l += shx32(l);
    const float c = g2 / l;
#pragma unroll
    for (int dt = 0; dt < 2; ++dt)
#pragma unroll
      for (int i = 0; i < 16; ++i) acc[dt][i] += c * O[dt][i];
  }
  bf16_t* orow = (bf16_t*)(p.ws + OFF_HB) + (size_t)(b * S + t) * LDX + head * 64;
#pragma unroll
  for (int dt = 0; dt < 2; ++dt)
#pragma unroll
    for (int gg = 0; gg < 4; ++gg) {
      u32x2 w; w.x = pack2(acc[dt][4 * gg], acc[dt][4 * gg + 1]); w.y = pack2(acc[dt][4 * gg + 2], acc[dt][4 * gg + 3]);
      *(u32x2*)(orow + dt * 32 + 8 * gg + 4 * h) = w;
    }
}

template <bool MASKED>
DI void sb_weights(f32x16 (&Sx)[2], float& carry, int kt, int t, int h) {
#pragma unroll
      for (int mt = 1; mt >= 0; --mt) {
        float L[16];
#pragma unroll
        for (int i = 0; i < 16; ++i) {
          const float z = Sx[mt][i];
          const bool ok = !MASKED || (kt * 64 + mt * 32 + crow(i, h) < t);
          const float sp = fmaxf(z, 0.f) + __logf(1.f + __expf(-fabsf(z)));
          L[i] = ok ? -sp : 0.f;
          Sx[mt][i] = ok ? (z - sp) : NEG;
        }
        float G[4], Go[4];
#pragma unroll
        for (int gg = 0; gg < 4; ++gg) { G[gg] = (L[4 * gg] + L[4 * gg + 1]) + (L[4 * gg + 2] + L[4 * gg + 3]); Go[gg] = shx32(G[gg]); }
        float T[4];
        T[3] = 0.f; T[2] = G[3] + Go[3]; T[1] = T[2] + (G[2] + Go[2]); T[0] = T[1] + (G[1] + Go[1]);
        const float tot = T[0] + (G[0] + Go[0]);
#pragma unroll
        for (int gg = 0; gg < 4; ++gg) {
          const float s3 = carry + T[gg] + (h ? 0.f : Go[gg]);
          const float s2 = s3 + L[4 * gg + 3], s1 = s2 + L[4 * gg + 2], s0 = s1 + L[4 * gg + 1];
          Sx[mt][4 * gg + 3] = __expf(Sx[mt][4 * gg + 3] + s3);
          Sx[mt][4 * gg + 2] = __expf(Sx[mt][4 * gg + 2] + s2);
          Sx[mt][4 * gg + 1] = __expf(Sx[mt][4 * gg + 1] + s1);
          Sx[mt][4 * gg + 0] = __expf(Sx[mt][4 * gg + 0] + s0);
        }
        carry += tot;
      }
}

DI void sb_item(const Params& p_, int b, int hh, int qt, unsigned char* smem) {
  Params p = p_; p.ws = launder(p.ws);
  const int tid = otid(), lane = tid & 63, wid = tid >> 6, r = lane & 31, h = lane >> 5;
  bf16_t* sK = (bf16_t*)smem; bf16_t* sV = sK + 64 * 72;
  unsigned char* big = p.ws + OFF_BIG;
  const bf16_t* Qb = (const bf16_t*)big; const bf16_t* Kb = (const bf16_t*)(big + 32 * MiB); const bf16_t* VTb = (const bf16_t*)(big + 64 * MiB);
  const int q0 = qt * 128 + wid * 32, t = q0 + r;
  bf16x8 qf[4]; load_q(qf, Qb + ((size_t)(b * 16 + hh) * S + t) * 64, h);
  const bf16_t* Kg = Kb + (size_t)(b * 16 + hh) * S * 64;
  const bf16_t* VTg = VTb + (size_t)(b * 16 + hh) * 64 * SP;
  const int kt_hi = 2 * qt + 1, my_hi = (q0 + 31) >> 6;
  f32x16 O[2]; zero_o<2>(O);
  float carry = 0.f;
  TR_<2> kr, vr; tload(kr, Kg + (size_t)kt_hi * 64 * 64, 64, tid); tload(vr, VTg + kt_hi * 64, SP, tid);
  __syncthreads();
  for (int kt = kt_hi; kt >= 0; --kt) {
    tstore72(kr, sK, tid); tstore68(vr, sV, tid);
    __syncthreads();
    if (kt > 0) { tload(kr, Kg + (size_t)(kt - 1) * 64 * 64, 64, tid); tload(vr, VTg + (kt - 1) * 64, SP, tid); }
    if (kt <= my_hi) {
      f32x16 Sx[2]; qk_tile(sK, qf, Sx, r, h);
      if (kt * 64 + 63 >= q0) sb_weights<true>(Sx, carry, kt, t, h);
      else { __builtin_amdgcn_sched_barrier(0); sb_weights<false>(Sx, carry, kt, t, h); __builtin_amdgcn_sched_barrier(0); }
      pv_tile<2>(sV, Sx, O, r, h);
    }
#if SB_EARLY
    {
      volatile int* flg = (volatile int*)(smem + 18432) + (kt & 1) * 4;
      const bool wall = (__ballot(carry < -110.f) == ~0ull);
      if (lane == 0) flg[wid] = wall ? 1 : 0;
      __syncthreads();
      if (flg[0] & flg[1] & flg[2] & flg[3]) break;
    }
#else
    __syncthreads();
#endif
  }
  bf16_t* orow = (bf16_t*)(p.ws + OFF_HB) + (size_t)(b * S + t) * LDX + hh * 64;
#pragma unroll
  for (int dt = 0; dt < 2; ++dt)
#pragma unroll
    for (int gg = 0; gg < 4; ++gg) {
      u32x2 w; w.x = pack2(O[dt][4 * gg], O[dt][4 * gg + 1]); w.y = pack2(O[dt][4 * gg + 2], O[dt][4 * gg + 3]);
      *(u32x2*)(orow + dt * 32 + 8 * gg + 4 * h) = w;
    }
}

DI void final_phase(float* xio, const float* g) {
  const int tidx = otid(), lane = tidx & 63, gw = blockIdx.x * 4 + (tidx >> 6), nw = gridDim.x * 4;
  for (int row = gw; row < M; row += nw) {
    float* xr = xio + (size_t)row * DM;
    f32x4 v[4]; float ss = 0.f;
#pragma unroll
    for (int i = 0; i < 4; ++i) { v[i] = *(const f32x4*)(xr + (i * 64 + lane) * 4); ss += v[i].x * v[i].x + v[i].y * v[i].y + v[i].z * v[i].z + v[i].w * v[i].w; }
#pragma unroll
    for (int o = 1; o < 64; o <<= 1) ss += __shfl_xor(ss, o);
    const float rinv = rsqrtf(ss * (1.f / DM) + 1e-6f);
#pragma unroll
    for (int i = 0; i < 4; ++i) {
      const f32x4 gg = *(const f32x4*)(g + (i * 64 + lane) * 4);
      f32x4 o; o.x = v[i].x * rinv * gg.x; o.y = v[i].y * rinv * gg.y; o.z = v[i].z * rinv * gg.z; o.w = v[i].w * rinv * gg.w;
      *(f32x4*)(xr + (i * 64 + lane) * 4) = o;
    }
  }
}
DI void xprep_phase(const float* xin, bf16_t* xb, float* ssq) {
  const int tidx = otid(), lane = tidx & 63, gw = blockIdx.x * 4 + (tidx >> 6), nw = gridDim.x * 4;
  for (int row = gw; row < M; row += nw) {
    const float* xr = xin + (size_t)row * DM;
    f32x4 v[4]; float ss = 0.f;
#pragma unroll
    for (int i = 0; i < 4; ++i) { v[i] = *(const f32x4*)(xr + (i * 64 + lane) * 4); ss += v[i].x * v[i].x + v[i].y * v[i].y + v[i].z * v[i].z + v[i].w * v[i].w; }
#pragma unroll
    for (int o = 1; o < 64; o <<= 1) ss += __shfl_xor(ss, o);
#pragma unroll
    for (int i = 0; i < 4; ++i) *(u32x2*)(xb + (size_t)row * LDX + (i * 64 + lane) * 4) = pack4(v[i].x, v[i].y, v[i].z, v[i].w);
    if (lane < 16) ssq[(size_t)row * 16 + lane] = lane == 0 ? ss : 0.f;
  }
}

struct TJob { const float* src; bf16_t* dst; const float* ks; int K, N, mode, ldd; };
DI TJob get_job(const Params& p, int j) {
  TJob t; t.ks = nullptr; t.ldd = LDX;
  unsigned char* ws = p.ws;
  if (j < 2) { t.src = p.even_w_in + (size_t)j * 1024 * 2840; t.dst = (bf16_t*)(ws + OFF_WEI) + (size_t)j * EN * LDX; t.K = 1024; t.N = 2840; t.mode = 1; t.ks = p.norm_mix + (2 * j) * DM; }
  else if (j < 4) { int e = j - 2; t.src = p.even_w_out + (size_t)e * 1024 * 1024; t.dst = (bf16_t*)(ws + OFF_WEO) + (size_t)e * 1024 * LDX; t.K = 1024; t.N = 1024; t.mode = 0; }
  else if (j < 6) { int e = j - 4; t.src = p.odd_w_in + (size_t)e * 1024 * 3072; t.dst = (bf16_t*)(ws + OFF_WOI) + (size_t)e * 3072 * LDX; t.K = 1024; t.N = 3072; t.mode = 0; t.ks = p.norm_mix + (2 * e + 1) * DM; }
  else if (j < 8) { int e = j - 6; t.src = p.odd_w_out + (size_t)e * 1024 * 1024; t.dst = (bf16_t*)(ws + OFF_WOO) + (size_t)e * 1024 * LDX; t.K = 1024; t.N = 1024; t.mode = 0; }
  else if (j < 10) { int e = j - 8; t.src = p.cmp_w_k + (size_t)e * 2048 * 64; t.dst = (bf16_t*)(ws + OFF_CMPW) + (size_t)(e * 2 + 0) * 128 * 2048; t.K = 2048; t.N = 64; t.mode = 0; t.ldd = 2048; }
  else { int e = j - 10; t.src = p.cmp_w_v + (size_t)e * 2048 * 64; t.dst = (bf16_t*)(ws + OFF_CMPW) + (size_t)(e * 2 + 1) * 128 * 2048; t.K = 2048; t.N = 64; t.mode = 0; t.ldd = 2048; }
  return t;
}
DI TJob ffn_job(const Params& p, int layer, int j) {
  TJob t; t.ks = nullptr; t.ldd = LDX;
  if (j == 0) { t.src = p.w_gate + (size_t)layer * 1024 * FH; t.dst = (bf16_t*)(p.ws + OFF_WGU); t.K = 1024; t.N = FH; t.mode = 2; t.ks = p.norm_ffn + layer * DM; }
  else if (j == 1) { t.src = p.w_up + (size_t)layer * 1024 * FH; t.dst = (bf16_t*)(p.ws + OFF_WGU); t.K = 1024; t.N = FH; t.mode = 3; t.ks = p.norm_ffn + layer * DM; }
  else { t.src = p.w_down + (size_t)layer * FH * 1024; t.dst = (bf16_t*)(p.ws + OFF_WDN); t.K = FH; t.N = 1024; t.mode = 0; t.ldd = LDF; }
  return t;
}
DI TJob layer_job(const Params& p, int layer, int j) {
  if (j < 3) return ffn_job(p, layer, j);
  if (j == 3) return get_job(p, (layer & 1) ? 6 + (layer >> 1) : 2 + (layer >> 1));
  return get_job(p, (layer & 1) ? 1 : 4 + (layer >> 1));
}
DI int layer_job_tiles(int layer, int j) { return j < 3 ? 704 : (j == 3 ? 256 : ((layer & 1) ? 720 : 768)); }
DI int layer_conv_items(int layer) { return layer == 3 ? 592 : ((layer & 1) ? 772 : 784); }
DI int map_col(int n, int mode) {
  if (mode == 0) return n;
  if (mode == 1) return n < 1280 ? n : (n < 1304 ? 2816 + (n - 1280) : n - 24);
  if (mode == 2) return (n >> 5) * 64 + (n & 31);
  return (n >> 5) * 64 + 32 + (n & 31);
}
DI void transpose_tile(const TJob& t, int lt, unsigned char* smem, int tid) {
  float* tl = (float*)smem;
  const int nkt = t.K >> 6, k0 = (lt % nkt) << 6, n0 = (lt / nkt) << 6;
  f32x4 v[4];
#pragma unroll
  for (int i = 0; i < 4; ++i) {
    const int k = i * 16 + (tid >> 4), n = (tid & 15) * 4;
    v[i] = (n0 + n < t.N) ? *(const f32x4*)(t.src + (size_t)(k0 + k) * t.N + n0 + n) : (f32x4){0.f, 0.f, 0.f, 0.f};
  }
#pragma unroll
  for (int i = 0; i < 4; ++i) {
    const int k = i * 16 + (tid >> 4), n = (tid & 15) * 4;
    const float sc = t.ks ? t.ks[k0 + k] : 1.f;
    tl[k * 65 + n] = v[i].x * sc; tl[k * 65 + n + 1] = v[i].y * sc; tl[k * 65 + n + 2] = v[i].z * sc; tl[k * 65 + n + 3] = v[i].w * sc;
  }
  __syncthreads();
#pragma unroll
  for (int i = 0; i < 8; ++i) {
    const int n = i * 8 + (tid >> 5), k2 = (tid & 31) * 2;
    if (n0 + n < t.N) *(unsigned*)(t.dst + (size_t)map_col(n0 + n, t.mode) * t.ldd + k0 + k2) = pack2(tl[k2 * 65 + n], tl[(k2 + 1) * 65 + n]);
  }
  __syncthreads();
}
DI void prep_phase(const Params& p, unsigned char* smem) {
  const int tid = otid();
  for (int tile = blockIdx.x; tile < 720 + 4 * 32; tile += gridDim.x) {
    const int j = tile < 720 ? 0 : 8 + (tile - 720) / 32, lt = tile < 720 ? tile : (tile - 720) % 32;
    const TJob t = get_job(p, j);
    transpose_tile(t, lt, smem, tid);
  }
  {
    const int gt = blockIdx.x * 256 + tid, nt = gridDim.x * 256;
    for (int i = gt; i < 2 * 104 * (LDX / 2); i += nt) {
      const int e = i / (104 * (LDX / 2)), rem = i % (104 * (LDX / 2));
      ((unsigned*)((bf16_t*)(p.ws + OFF_WEI) + (size_t)e * EN * LDX + (size_t)2840 * LDX))[rem] = 0u;
    }
    float* cosT = (float*)(p.ws + OFF_COS); float* sinT = (float*)(p.ws + OFF_SIN);
    for (int i = gt; i < S * 32; i += nt) {
      const int s = i >> 5, d = i & 31;
      const float inv = 1.0f / powf(10000.0f, (float)(2 * d) / 64.0f);
      const float ang = (float)s * inv;
      cosT[i] = cosf(ang); sinT[i] = sinf(ang);
    }
  }
  const int nb = gridDim.x;
  for (int jc = blockIdx.x; jc < 128; jc += nb) {
    const int j = jc >> 5, c = jc & 31, e = j >> 1, kv = j & 1, w = tid >> 6, d = tid & 63;
    const float* pos = (kv ? p.cmp_pos_v : p.cmp_pos_k) + (size_t)e * 2048 + c * 64 + w * 16;
    const float* wt = (kv ? p.cmp_w_v : p.cmp_w_k) + ((size_t)e * 2048 + c * 64 + w * 16) * 64 + d;
    float s = 0.f;
#pragma unroll
    for (int k = 0; k < 16; ++k) s += pos[k] * wt[(size_t)k * 64];
    float* red = (float*)smem;
    __syncthreads();
    red[tid] = s;
    __syncthreads();
    if (tid < 64) ((float*)(p.ws + OFF_CPART))[(j * 32 + c) * 64 + tid] = (red[tid] + red[64 + tid]) + (red[128 + tid] + red[192 + tid]);
  }
  if (blockIdx.x == (128 % nb) && tid < 2) {
    const int e = tid;
    float s1 = 0.f, s2 = 0.f;
    for (int k = 0; k < 64; ++k) { s1 += p.lq1[e * 64 + k] * p.lk1[e * 64 + k]; s2 += p.lq2[e * 64 + k] * p.lk2[e * 64 + k]; }
    const float lam_init = 0.8f - 0.6f * expf(-0.3f * (float)(2 * e));
    ((float*)(p.ws + OFF_CBIAS + 2048))[e] = expf(s1) - expf(s2) + lam_init;
  }
  xprep_phase(p.x, (bf16_t*)(p.ws + OFF_XB), (float*)(p.ws + OFF_SSQ));
}

DI int fetch_item(unsigned* ctr, int* s_item) {
  __syncthreads();
  if (threadIdx.x == 0) *s_item = (int)atomicAdd(ctr, 1u);
  __syncthreads();
  return *s_item;
}
DI void ffn_conv_item(const Params& p_, int layer, int it, unsigned char* smem) {
  Params p = p_; p.ws = launder(p.ws); p.w_gate = launder(p.w_gate); p.w_up = launder(p.w_up); p.w_down = launder(p.w_down); p.norm_ffn = launder(p.norm_ffn);
  p.even_w_in = launder(p.even_w_in); p.even_w_out = launder(p.even_w_out); p.odd_w_in = launder(p.odd_w_in); p.odd_w_out = launder(p.odd_w_out); p.norm_mix = launder(p.norm_mix);
  const int tid = otid();
  for (int q = 0; q < 4; ++q) {
    int lt = it * 4 + q, j = 0;
    while (lt >= layer_job_tiles(layer, j)) { lt -= layer_job_tiles(layer, j); ++j; }
    const TJob t = layer_job(p, layer, j);
    transpose_tile(t, lt, smem, tid);
  }
}
DI void compress_item(const Params& p_, const EvenBufs& eb_, int e, int it, unsigned* done, unsigned char* smem) {
  const int tid = otid();
  Params p = p_; p.ws = launder(p.ws);
  const EvenBufs eb = even_bufs(p.ws + OFF_BIG);
  const int kv = it >> 3, tm = it & 7;
  float* sBias = (float*)(smem + 73728);
  if (tid < 64) {
    const float* part = (const float*)(p.ws + OFF_CPART) + (size_t)(e * 2 + kv) * 32 * 64 + tid;
    float s = 0.f;
    for (int c = 0; c < 32; ++c) s += part[c * 64];
    sBias[tid] = s;
  }
  __syncthreads();
  EpiCompress ep; ep.dst = kv ? eb.VCMPT : eb.KCMP; ep.sBias = sBias; ep.tr = kv;
  gemm_tile<true>(kv ? eb.VC : eb.KC, 1024, (const bf16_t*)(p.ws + OFF_CMPW) + (size_t)(e * 2 + kv) * 128 * 2048, 2048, 2048, nullptr, tm, 0, ep, smem, 0);
  asm volatile("s_waitcnt vmcnt(0)" ::: "memory");
  __syncthreads();
  if (tid == 0) __hip_atomic_fetch_add(done, 1u, __ATOMIC_RELEASE, __HIP_MEMORY_SCOPE_AGENT);
}
DI void wait_count(unsigned* ctr, unsigned target) {
  if (threadIdx.x == 0) {
    while (__hip_atomic_load(ctr, __ATOMIC_RELAXED, __HIP_MEMORY_SCOPE_AGENT) < target) __builtin_amdgcn_s_sleep(8);
    __builtin_amdgcn_fence(__ATOMIC_ACQUIRE, "agent");
    asm volatile("s_waitcnt vmcnt(0)" ::: "memory");
  }
  __syncthreads();
}


#define XB_TMO      128
#define XB_XCNT(j)  (256  + 64 * (j))
#define XB_XSUB(j)  (1280 + 64 * (j))
#define XB_XGEN(j)  (2304 + 64 * (j))
#define XB_TOP      3328
#define XB_TOPGEN   3392
#define XCD_BAR_WORDS 3456
#define XB_SPIN_CAP (1u << 18)
#define LAS __attribute__((address_space(3)))
DI unsigned xb_ld(unsigned* p) { return __hip_atomic_load(p, __ATOMIC_RELAXED, __HIP_MEMORY_SCOPE_AGENT); }
DI unsigned xb_add(unsigned* p, unsigned v) { return __hip_atomic_fetch_add(p, v, __ATOMIC_RELAXED, __HIP_MEMORY_SCOPE_AGENT); }
DI unsigned xb_xcc_id() { return (unsigned)__builtin_amdgcn_s_getreg((3 << 11) | 20) & 0xFu; }
#define XB_SPIN(cond, bar) do { unsigned _sp = 0; while (cond) { __builtin_amdgcn_s_sleep(1); \
    if ((++_sp & 255u) == 0u) { if (xb_ld(&(bar)[XB_TMO])) break; if (_sp > XB_SPIN_CAP) { atomicAdd(&(bar)[XB_TMO], 1u); break; } } } } while (0)
struct XcdBarrier { unsigned* bar; unsigned x; volatile LAS unsigned* st; };
DI XcdBarrier xcd_barrier_post(unsigned* bar, volatile LAS unsigned* st) {
  XcdBarrier b; b.bar = bar; b.x = xb_xcc_id(); b.st = st;
  if (threadIdx.x == 0) (void)xb_add(&bar[XB_XCNT(b.x)], 1u);
  return b;
}
DI void xcd_barrier_complete(unsigned* bar, unsigned x, unsigned& nloc, unsigned& nx) {
  const unsigned G = gridDim.x * gridDim.y * gridDim.z;
  unsigned sum, cnt, mine, sp = 0u;
  for (;;) {
    sum = 0u; cnt = 0u; mine = 0u;
#pragma unroll
    for (unsigned j = 0; j < 16; ++j) { const unsigned c = xb_ld(&bar[XB_XCNT(j)]); sum += c; cnt += (c > 0u) ? 1u : 0u; mine = (j == x) ? c : mine; }
    if (sum == G) break;
    __builtin_amdgcn_s_sleep(1);
    if ((++sp & 255u) == 0u) { if (xb_ld(&bar[XB_TMO])) break; if (sp > XB_SPIN_CAP) { atomicAdd(&bar[XB_TMO], 1u); break; } }
  }
  nloc = mine > 0u ? mine : 1u; nx = cnt > 0u ? cnt : 1u;
}
DI void xcd_barrier(const XcdBarrier& b_) {
  XcdBarrier b = b_; b.x = xb_xcc_id(); b.bar = launder(b.bar);
  asm volatile("s_waitcnt vmcnt(0)" ::: "memory");
  __syncthreads();
  if (threadIdx.x == 0) {
    unsigned* bar = b.bar;
    __builtin_amdgcn_s_waitcnt(0);
    unsigned nloc = b.st[0], nx = b.st[1];
    if (nloc == 0u) { xcd_barrier_complete(bar, b.x, nloc, nx); b.st[0] = nloc; b.st[1] = nx; }
    const unsigned old = xb_add(&bar[XB_XSUB(b.x)], 1u);
    const unsigned gen = old / nloc;
    if (old + 1u == (gen + 1u) * nloc) {
      __builtin_amdgcn_fence(__ATOMIC_RELEASE, "agent");
      asm volatile("s_waitcnt vmcnt(0)" ::: "memory");
      const unsigned og = xb_add(&bar[XB_TOP], 1u);
      const unsigned tg = og / nx;
      if (og + 1u == (tg + 1u) * nx) xb_add(&bar[XB_TOPGEN], 1u);
      else XB_SPIN(xb_ld(&bar[XB_TOPGEN]) == tg, bar);
      __builtin_amdgcn_fence(__ATOMIC_ACQUIRE, "agent");
      xb_add(&bar[XB_XGEN(b.x)], 1u);
      asm volatile("s_waitcnt vmcnt(0)" ::: "memory");
    } else {
      XB_SPIN(xb_ld(&bar[XB_XGEN(b.x)]) == gen, bar);
      __builtin_amdgcn_fence(__ATOMIC_ACQUIRE, "agent");
      asm volatile("s_waitcnt vmcnt(0)" ::: "memory");
    }
  }
  __syncthreads();
}

__global__ void __launch_bounds__(256, 2) mega(Params p_in, int ph_begin, int ph_end) {
  __shared__ __attribute__((aligned(16))) unsigned char smem[74752];
  __shared__ int s_item;
  __shared__ uint4 xb_words;
  if (ph_begin == 0x7fffffff) cg::this_grid().sync();
  int ph = 0;
  unsigned* xbar = (unsigned*)(p_in.ws + OFF_BAR);
  if (threadIdx.x == 0) xb_words = make_uint4(0u, 0u, 0u, 0u);
  __syncthreads();
  XcdBarrier gbar; gbar.bar = xbar; gbar.x = 0; gbar.st = (volatile LAS unsigned*)&xb_words;
#define PHASE_BEGIN { Params p = p_in; p.ws = launder(p.ws); p.out = launder(p.out); p.x = launder(p.x); \
    unsigned char* ws = p.ws; bf16_t* hb = (bf16_t*)(ws + OFF_HB); bf16_t* xb = (bf16_t*)(ws + OFF_XB); float* ssq = (float*)(ws + OFF_SSQ); \
    unsigned char* big = ws + OFF_BIG; unsigned* ctrs = (unsigned*)(ws + OFF_CTRL); \
    const float* cosT = (const float*)(ws + OFF_COS); const float* sinT = (const float*)(ws + OFF_SIN); const EvenBufs eb = even_bufs(big); \
    (void)hb; (void)xb; (void)ssq; (void)ctrs; (void)cosT; (void)sinT; (void)eb; \
    const int nrep = ((REPEAT_MASK >> ph) & 1ull) ? 2 : 1; for (int rep = 0; rep < nrep; ++rep) { if (rep) xcd_barrier(gbar);
#define PHASE_END  } xcd_barrier(gbar); } ++ph;

  gbar = xcd_barrier_post(xbar, (volatile LAS unsigned*)&xb_words);
  { Params p = p_in; p.ws = launder(p.ws); p.x = launder(p.x); prep_phase(p, smem); }
  xcd_barrier(gbar);
  ++ph;

  for (int layer = 0; layer < 4; ++layer) {
    const int e = layer >> 1;
    if ((layer & 1) == 0) {
      PHASE_BEGIN
        EpiEvenIn epi; epi.eb = eb; epi.cosT = cosT; epi.sinT = sinT;
        gemm_phase(xb, LDX, (const bf16_t*)(ws + OFF_WEI) + (size_t)e * EN * LDX, LDX, M, EN, 1024, ssq, epi, smem);
      PHASE_END
      PHASE_BEGIN
        unsigned* done = ctrs + 16 + layer + 8 * rep;
        const int pmq = rep ? PROBE_MODE : 0;
        for (;;) {
          const int idx = fetch_item(ctrs + layer + 8 * rep, &s_item);
          const int nconv = layer_conv_items(layer);
          if (idx >= 16 + nconv + 512) break;
          if (idx < 16) { if (pmq == 0 || pmq == 4) compress_item(p, eb, e, idx, done, smem); }
          else if (idx < 16 + nconv) { if (pmq == 0 || pmq == 5) ffn_conv_item(p, layer, idx - 16, smem); }
          else if (pmq == 0 || pmq == 3) { const int q = idx - 16 - nconv; diff_item(p, eb, e, (q >> 2) & 3, q & 3, 31 - (q >> 4), smem); }
        }
        if (pmq == 0 || pmq == 4) {
          wait_count(done, 16u);
          for (;;) {
            const int idx = fetch_item(ctrs + 32 + layer + 8 * rep, &s_item);
            if (idx >= 1024) break;
            nsa_item(p, eb, (idx >> 1) & 3, idx & 1, 127 - (idx >> 3), smem);
          }
        }
      PHASE_END
      PHASE_BEGIN
        EpiResid er; er.rin = layer == 0 ? p.x : p.out; er.out = p.out; er.xb = xb; er.ssq = ssq;
        gemm_phase(hb, LDX, (const bf16_t*)(ws + OFF_WEO) + (size_t)e * 1024 * LDX, LDX, M, 1024, 1024, nullptr, er, smem);
      PHASE_END
    } else {
      PHASE_BEGIN
        EpiOddIn epi; epi.Q = (bf16_t*)big; epi.K = (bf16_t*)(big + 32 * MiB); epi.VT = (bf16_t*)(big + 64 * MiB);
        gemm_phase(xb, LDX, (const bf16_t*)(ws + OFF_WOI) + (size_t)e * 3072 * LDX, LDX, M, 3072, 1024, ssq, epi, smem);
      PHASE_END
      PHASE_BEGIN
        for (;;) {
          const int idx = fetch_item(ctrs + layer + 8 * rep, &s_item);
          const int nconv = layer_conv_items(layer);
          if (idx >= nconv + 2048) break;
          if (idx < 2048) sb_item(p, (idx >> 4) & 3, idx & 15, 31 - (idx >> 6), smem);
          else ffn_conv_item(p, layer, idx - 2048, smem);
        }
      PHASE_END
      PHASE_BEGIN
        EpiResid er; er.rin = p.out; er.out = p.out; er.xb = xb; er.ssq = ssq;
        gemm_phase(hb, LDX, (const bf16_t*)(ws + OFF_WOO) + (size_t)e * 1024 * LDX, LDX, M, 1024, 1024, nullptr, er, smem);
      PHASE_END
    }
    PHASE_BEGIN
      EpiSwiGLU es; es.act = (bf16_t*)big;
      gemm_phase(xb, LDX, (const bf16_t*)(ws + OFF_WGU), LDX, M, 5632, 1024, ssq, es, smem, rep ? PROBE_MODE : 0);
    PHASE_END
    PHASE_BEGIN
      EpiResid er; er.rin = p.out; er.out = p.out; er.xb = xb; er.ssq = ssq;
      gemm_phase((const bf16_t*)big, LDF, (const bf16_t*)(ws + OFF_WDN), LDF, M, 1024, FH, nullptr, er, smem);
    PHASE_END
  }
  { Params p = p_in; p.out = launder(p.out); final_phase(p.out, p.norm_final); }
}

extern "C" void kernel_launch(void* const* d_in, const int* in_sizes, int n_in, void* d_out, int out_size, void* d_ws, size_t ws_size,
                              hipStream_t stream) {
  Params p; memset(&p, 0, sizeof(p));
  p.x = (const float*)d_in[0]; p.norm_mix = (const float*)d_in[1]; p.norm_ffn = (const float*)d_in[2]; p.norm_final = (const float*)d_in[3];
  p.even_w_in = (const float*)d_in[4]; p.even_w_out = (const float*)d_in[5]; p.cmp_pos_k = (const float*)d_in[6]; p.cmp_w_k = (const float*)d_in[7];
  p.cmp_pos_v = (const float*)d_in[8]; p.cmp_w_v = (const float*)d_in[9]; p.lq1 = (const float*)d_in[10]; p.lk1 = (const float*)d_in[11];
  p.lq2 = (const float*)d_in[12]; p.lk2 = (const float*)d_in[13]; p.subln = (const float*)d_in[14]; p.odd_w_in = (const float*)d_in[15];
  p.odd_w_out = (const float*)d_in[16]; p.w_gate = (const float*)d_in[17]; p.w_up = (const float*)d_in[18]; p.w_down = (const float*)d_in[19];
  p.out = (float*)d_out; p.ws = (unsigned char*)d_ws;
  static int grid_blocks = 0;
  if (!grid_blocks) {
    int dev = 0, cus = 0, per_cu = 0;
    (void)hipGetDevice(&dev);
    (void)hipDeviceGetAttribute(&cus, hipDeviceAttributeMultiprocessorCount, dev);
    (void)hipOccupancyMaxActiveBlocksPerMultiprocessor(&per_cu, mega, 256, 0);
    if (per_cu > 2) per_cu = 2;
    if (per_cu < 1) per_cu = 1;
    grid_blocks = cus * per_cu;
  }
  int pb = 0, pe = 1000;
  void* args[] = {&p, &pb, &pe};
  (void)hipMemsetAsync((unsigned char*)d_ws + OFF_CTRL, 0, 4096, stream);
  (void)hipMemsetAsync((unsigned char*)d_ws + OFF_BAR, 0, 16384, stream);
  hipError_t err = hipLaunchCooperativeKernel((void*)mega, dim3(grid_blocks), dim3(256), args, 0, stream);
  if (err != hipSuccess) fprintf(stderr, "cooperative launch failed: %s (grid %d)\n", hipGetErrorString(err), grid_blocks);
}
```

```cpp
#include <hip/hip_runtime.h>
#include <hip/hip_cooperative_groups.h>
#include <cstdio>
#include <cstring>
namespace cg = cooperative_groups;

#ifndef SB_EARLY
#define SB_EARLY 1
#endif
#ifndef PROBE_MODE
#define PROBE_MODE 0
#endif
#ifndef REPEAT_MASK
#define REPEAT_MASK 0ull
#endif

#define DI __device__ __forceinline__
typedef unsigned short bf16_t;
typedef unsigned long long u64;
typedef short bf16x8 __attribute__((ext_vector_type(8)));
typedef short bf16x4 __attribute__((ext_vector_type(4)));
typedef float f32x16 __attribute__((ext_vector_type(16)));
typedef float f32x4 __attribute__((ext_vector_type(4)));
typedef float f32x2 __attribute__((ext_vector_type(2)));
typedef unsigned u32x4 __attribute__((ext_vector_type(4)));
typedef unsigned u32x2 __attribute__((ext_vector_type(2)));
typedef __bf16 bf2_t __attribute__((ext_vector_type(2)));

DI unsigned pack2(float a, float b) { bf2_t v = __builtin_convertvector((f32x2){a, b}, bf2_t); return __builtin_bit_cast(unsigned, v); }
DI bf16_t tobf(float a) { return (bf16_t)(pack2(a, 0.f) & 0xffffu); }
#define MFMA(a, b, c) __builtin_amdgcn_mfma_f32_32x32x16_bf16((a), (b), (c), 0, 0, 0)
DI int crow(int i, int h) { return (i & 3) + 8 * (i >> 2) + 4 * h; }
DI float shx32(float v) { return __shfl_xor(v, 32); }
DI int otid() { int t = threadIdx.x; asm volatile("" : "+v"(t)); return t; }
template <class T> DI T* launder(T* q) { asm volatile("" : "+s"(q)); return q; }

constexpr int S = 4096, M = 16384, DM = 1024, FH = 2816, EN = 2944;
constexpr int LDX = 1088, LDF = 2880, SP = 4224;
constexpr float L2E = 1.4426950408889634f;
constexpr float NEG = -1e30f;

constexpr size_t MiB = 1048576;
constexpr size_t OFF_CTRL = 0;
constexpr size_t OFF_COS = 4096;
constexpr size_t OFF_SIN = OFF_COS + 524288;
constexpr size_t OFF_CBIAS = OFF_SIN + 524288;
constexpr size_t OFF_CPART = OFF_CBIAS + 4096;
constexpr size_t OFF_BAR = OFF_CPART + 32768;
constexpr size_t OFF_CMPW = OFF_BAR + 16384;
constexpr size_t OFF_WEI = OFF_CMPW + 2097152;
constexpr size_t OFF_WEO = OFF_WEI + (size_t)2 * EN * LDX * 2;
constexpr size_t OFF_WOI = OFF_WEO + (size_t)2 * 1024 * LDX * 2;
constexpr size_t OFF_WOO = OFF_WOI + (size_t)2 * 3072 * LDX * 2;
constexpr size_t OFF_WGU = OFF_WOO + (size_t)2 * 1024 * LDX * 2;
constexpr size_t OFF_WDN = OFF_WGU + (size_t)5632 * LDX * 2;
constexpr size_t OFF_SSQ = OFF_WDN + (size_t)1024 * LDF * 2;
constexpr size_t OFF_HB = OFF_SSQ + 1048576;
constexpr size_t OFF_XB = OFF_HB + (size_t)M * LDX * 2;
constexpr size_t OFF_BIG = OFF_XB + (size_t)M * LDX * 2;
static_assert(OFF_BIG + 98 * MiB < 250 * MiB, "workspace budget");

struct Params {
  const float *x, *norm_mix, *norm_ffn, *norm_final, *even_w_in, *even_w_out, *cmp_pos_k, *cmp_w_k, *cmp_pos_v, *cmp_w_v;
  const float *lq1, *lk1, *lq2, *lk2, *subln, *odd_w_in, *odd_w_out, *w_gate, *w_up, *w_down;
  float* out;
  unsigned char* ws;
};

struct EvenBufs { bf16_t *QN, *KC, *VC, *KS, *VST, *KW, *VWT, *DQ, *DK, *DVT, *KCMP, *VCMPT; float* gate; };
DI EvenBufs even_bufs(unsigned char* big) {
  constexpr size_t VSTB = (size_t)8 * 64 * SP * 2, DVTB = (size_t)16 * 128 * SP * 2;
  EvenBufs e; unsigned char* q = big;
  e.QN = (bf16_t*)q; q += 16 * MiB; e.KC = (bf16_t*)q; q += 4 * MiB; e.VC = (bf16_t*)q; q += 4 * MiB; e.KS = (bf16_t*)q; q += 4 * MiB;
  e.VST = (bf16_t*)q; q += VSTB; e.KW = (bf16_t*)q; q += 4 * MiB; e.VWT = (bf16_t*)q; q += VSTB; e.DQ = (bf16_t*)q; q += 16 * MiB;
  e.DK = (bf16_t*)q; q += 16 * MiB; e.DVT = (bf16_t*)q; q += DVTB; e.gate = (float*)q; q += 1572864;
  e.KCMP = (bf16_t*)q; q += 262144; e.VCMPT = (bf16_t*)q;
  return e;
}

template <int NV> struct TR_ { u32x4 v[NV]; };
typedef const __attribute__((address_space(1))) u32x4* gvec_t;
DI u32x4 gload16(const bf16_t* p) { return *(gvec_t)(unsigned long long)p; }
template <int NV> DI void tload(TR_<NV>& t, const bf16_t* g, size_t ld, int tid) {
#pragma unroll
  for (int i = 0; i < NV; ++i) t.v[i] = gload16(g + (size_t)((tid >> 3) + 32 * i) * ld + (tid & 7) * 8);
  __builtin_amdgcn_sched_barrier(0);
}
template <int NV> DI void tstore72(const TR_<NV>& t, bf16_t* s, int tid) {
#pragma unroll
  for (int i = 0; i < NV; ++i) *(u32x4*)(s + ((tid >> 3) + 32 * i) * 72 + (tid & 7) * 8) = t.v[i];
}
template <int NV> DI void tstore68(const TR_<NV>& t, bf16_t* s, int tid) {
#pragma unroll
  for (int i = 0; i < NV; ++i) {
    bf16_t* d = s + ((tid >> 3) + 32 * i) * 68 + (tid & 7) * 8;
    *(u32x2*)d = (u32x2){t.v[i].x, t.v[i].y};
    *(u32x2*)(d + 4) = (u32x2){t.v[i].z, t.v[i].w};
  }
}

constexpr int LDT = 40;
struct GRegs { u32x4 a[4], b[2]; };
DI void g_issue(GRegs& g, const bf16_t* Ag, size_t lda, const bf16_t* Bg, size_t ldb, unsigned offA, unsigned offB, int kt) {
#pragma unroll
  for (int i = 0; i < 4; ++i) g.a[i] = *(gvec_t)((unsigned long long)(Ag + (size_t)(64 * i) * lda + kt * 32) + offA);
#pragma unroll
  for (int i = 0; i < 2; ++i) g.b[i] = *(gvec_t)((unsigned long long)(Bg + (size_t)(64 * i) * ldb + kt * 32) + offB);
}
DI void g_write(const GRegs& g, bf16_t* cA, bf16_t* cB, int tid) {
  const int row = tid >> 2, pc = (tid & 3) ^ ((tid >> 4) & 3);
#pragma unroll
  for (int i = 0; i < 4; ++i) *(u32x4*)(cA + (row + 64 * i) * 32 + pc * 8) = g.a[i];
#pragma unroll
  for (int i = 0; i < 2; ++i) *(u32x4*)(cB + (row + 64 * i) * 32 + pc * 8) = g.b[i];
}
constexpr int STG_A = 8192, STG = 12288;
DI void dma_issue(const bf16_t* Ag, size_t lda, const bf16_t* Bg, size_t ldb, int kt, bf16_t* stage, int wid, int lane) {
  const int rl = lane >> 2, c = (lane & 3) ^ ((lane >> 4) & 3);
#pragma unroll
  for (int i = 0; i < 4; ++i) {
    const int j = wid + 4 * i;
    __builtin_amdgcn_global_load_lds((const unsigned*)(Ag + (size_t)(16 * j + rl) * lda + kt * 32 + c * 8), (unsigned*)(stage + j * 512), 16, 0, 0);
  }
#pragma unroll
  for (int i = 0; i < 2; ++i) {
    const int j = wid + 4 * i;
    __builtin_amdgcn_global_load_lds((const unsigned*)(Bg + (size_t)(16 * j + rl) * ldb + kt * 32 + c * 8), (unsigned*)(stage + STG_A + j * 512), 16, 0, 0);
  }
}
template <bool VT>
DI void g_compute(const bf16_t* cA, const bf16_t* cB, f32x16 (&acc)[4][2], int wm, int wn, int r, int h) {
  bf16x8 af[2][4], bfr[2][2];
#pragma unroll
  for (int s = 0; s < 2; ++s) {
#pragma unroll
    for (int ni = 0; ni < 2; ++ni) bfr[s][ni] = *(const bf16x8*)(cB + (wn * 64 + ni * 32 + r) * 32 + (((2 * s + h) ^ (r >> 2)) & 3) * 8);
#pragma unroll
    for (int mi = 0; mi < 4; ++mi) af[s][mi] = *(const bf16x8*)(cA + (wm * 128 + mi * 32 + r) * 32 + (((2 * s + h) ^ (r >> 2)) & 3) * 8);
  }
  __builtin_amdgcn_sched_barrier(0);
#pragma unroll
  for (int s = 0; s < 2; ++s)
#pragma unroll
    for (int mi = 0; mi < 4; ++mi)
#pragma unroll
      for (int ni = 0; ni < 2; ++ni) {
        if (VT) acc[mi][ni] = MFMA(af[s][mi], bfr[s][ni], acc[mi][ni]);
        else acc[mi][ni] = MFMA(bfr[s][ni], af[s][mi], acc[mi][ni]);
      }
}
#define DSR(dst, addr, off) asm volatile("ds_read_b128 %0, %1 offset:" #off : "=&v"(dst) : "v"(addr))
template <bool VT>
DI void g_compute_asm(unsigned aA0, unsigned aA1, unsigned aB0, unsigned aB1, f32x16 (&acc)[4][2]) {
  bf16x8 a0[4], a1[4], b0[2], b1[2];
  DSR(b0[0], aB0, 0); DSR(b0[1], aB0, 2048);
  DSR(a0[0], aA0, 0); DSR(a0[1], aA0, 2048); DSR(a0[2], aA0, 4096); DSR(a0[3], aA0, 6144);
  DSR(b1[0], aB1, 0); DSR(b1[1], aB1, 2048);
  DSR(a1[0], aA1, 0); DSR(a1[1], aA1, 2048); DSR(a1[2], aA1, 4096); DSR(a1[3], aA1, 6144);
  asm volatile("s_waitcnt lgkmcnt(6)" : "+v"(b0[0]), "+v"(b0[1]), "+v"(a0[0]), "+v"(a0[1]), "+v"(a0[2]), "+v"(a0[3]));
#pragma unroll
  for (int mi = 0; mi < 4; ++mi)
#pragma unroll
    for (int ni = 0; ni < 2; ++ni) {
      if (VT) acc[mi][ni] = MFMA(a0[mi], b0[ni], acc[mi][ni]);
      else acc[mi][ni] = MFMA(b0[ni], a0[mi], acc[mi][ni]);
    }
  __builtin_amdgcn_sched_barrier(0);
  asm volatile("s_waitcnt lgkmcnt(0)" : "+v"(b1[0]), "+v"(b1[1]), "+v"(a1[0]), "+v"(a1[1]), "+v"(a1[2]), "+v"(a1[3]));
#pragma unroll
  for (int mi = 0; mi < 4; ++mi)
#pragma unroll
    for (int ni = 0; ni < 2; ++ni) {
      if (VT) acc[mi][ni] = MFMA(a1[mi], b1[ni], acc[mi][ni]);
      else acc[mi][ni] = MFMA(b1[ni], a1[mi], acc[mi][ni]);
    }
}
template <bool VT>
DI int gemm_kloop(const bf16_t* Ag, size_t lda, const bf16_t* Bg, size_t ldb, int nk, bf16_t* ring, f32x16 (&acc)[4][2], int tid, int wm, int wn,
                  int r, int h, int st0, bool pre, const bf16_t* AgN, const bf16_t* BgN) {
  const int wid = tid >> 6, lane = tid & 63;
  const unsigned base = (unsigned)(unsigned long long)ring;
  const int q = (r >> 2) & 3;
  const unsigned rA = base + (unsigned)(wm * 128 + r) * 64u, rB = base + (unsigned)STG_A * 2u + (unsigned)(wn * 64 + r) * 64u;
  const unsigned oA0 = rA + (unsigned)((h ^ q) & 3) * 16u, oA1 = rA + (unsigned)(((2 + h) ^ q) & 3) * 16u;
  const unsigned oB0 = rB + (unsigned)((h ^ q) & 3) * 16u, oB1 = rB + (unsigned)(((2 + h) ^ q) & 3) * 16u;
  int st = st0;
  if (!pre) {
    dma_issue(Ag, lda, Bg, ldb, 0, ring + st * STG, wid, lane);
    dma_issue(Ag, lda, Bg, ldb, 1, ring + (st == 2 ? 0 : st + 1) * STG, wid, lane);
  }
  for (int kt = 0; kt < nk - 1; ++kt) {
    asm volatile("s_waitcnt vmcnt(6)" ::: "memory");
    __builtin_amdgcn_s_barrier();
    if (kt + 2 < nk) dma_issue(Ag, lda, Bg, ldb, kt + 2, ring + (st == 0 ? 2 : st - 1) * STG, wid, lane);
    const unsigned so = (unsigned)st * (unsigned)(STG * 2);
    g_compute_asm<VT>(oA0 + so, oA1 + so, oB0 + so, oB1 + so, acc);
    st = st == 2 ? 0 : st + 1;
  }
  asm volatile("s_waitcnt vmcnt(0)" ::: "memory");
  __builtin_amdgcn_s_barrier();
  if (AgN) {
    const int s1 = st == 2 ? 0 : st + 1, s2 = s1 == 2 ? 0 : s1 + 1;
    dma_issue(AgN, lda, BgN, ldb, 0, ring + s1 * STG, wid, lane);
    dma_issue(AgN, lda, BgN, ldb, 1, ring + s2 * STG, wid, lane);
  }
  {
    const unsigned so = (unsigned)st * (unsigned)(STG * 2);
    g_compute_asm<VT>(oA0 + so, oA1 + so, oB0 + so, oB1 + so, acc);
  }
  asm volatile("s_waitcnt lgkmcnt(0)" ::: "memory");
  return st;
}
template <bool VT>
DI void gemm_kloop_simple(const bf16_t* Ag, size_t lda, const bf16_t* Bg, size_t ldb, int nk, bf16_t* sA, bf16_t* sB, f32x16 (&acc)[4][2], int tid, int wm,
                          int wn, int r, int h) {
  GRegs g0;
  const unsigned offA = (unsigned)(((tid >> 2) * lda + (tid & 3) * 8) * 2), offB = (unsigned)(((tid >> 2) * ldb + (tid & 3) * 8) * 2);
  g_issue(g0, Ag, lda, Bg, ldb, offA, offB, 0);
  for (int kt = 0; kt < nk; ++kt) {
    bf16_t* cA = sA + (kt & 1) * STG;
    bf16_t* cB = cA + STG_A;
    g_write(g0, cA, cB, tid);
    __syncthreads();
    if (kt + 1 < nk) g_issue(g0, Ag, lda, Bg, ldb, offA, offB, kt + 1);
    __builtin_amdgcn_sched_barrier(0);
    g_compute<VT>(cA, cB, acc, wm, wn, r, h);
  }
}
template <bool DEEP, class Epi>
DI int gemm_tile(const bf16_t* __restrict__ A, int lda, const bf16_t* __restrict__ Bt, int ldb, int K, const float* ssq, int tm, int tn, const Epi& epi,
                 unsigned char* smem, int pm, int st0 = 0, bool pre = false, int tmN = -1, int tnN = 0) {
  const int tid = otid();
  const int lane = tid & 63, wid = tid >> 6, r = lane & 31, h = lane >> 5, wm = wid >> 1, wn = wid & 1;
  bf16_t* sA = (bf16_t*)smem;
  bf16_t* sB = sA;
  float* sR = (float*)(smem + 73728);
  const int m0 = tm << 8, n0 = tn << 7;
  const bf16_t* Ag = A + (size_t)m0 * lda;
  const bf16_t* Bg = Bt + (size_t)n0 * ldb;
  if (ssq) {
    const f32x4* sp = (const f32x4*)(ssq + (size_t)(m0 + tid) * 16);
    const f32x4 a = sp[0], b = sp[1], c = sp[2], d = sp[3];
    const float tot = ((a.x + a.y) + (a.z + a.w)) + ((b.x + b.y) + (b.z + b.w)) + ((c.x + c.y) + (c.z + c.w)) + ((d.x + d.y) + (d.z + d.w));
    sR[tid] = rsqrtf(tot * (1.f / DM) + 1e-6f);
  }
  __syncthreads();
  f32x16 acc[4][2];
#pragma unroll
  for (int a = 0; a < 4; ++a)
#pragma unroll
    for (int b = 0; b < 2; ++b)
#pragma unroll
      for (int i = 0; i < 16; ++i) acc[a][b][i] = 0.f;
  const bool vt = epi.vtype(n0 + wn * 64);
  int st_last = 0;
  if (pm == 2) K >>= 1;
  if (DEEP) {
    const bf16_t* AgN = tmN >= 0 ? A + (size_t)(tmN << 8) * lda : nullptr;
    const bf16_t* BgN = Bt + (size_t)(tnN << 7) * ldb;
    if (vt) st_last = gemm_kloop<true>(Ag, lda, Bg, ldb, K >> 5, sA, acc, tid, wm, wn, r, h, st0, pre, AgN, BgN);
    else st_last = gemm_kloop<false>(Ag, lda, Bg, ldb, K >> 5, sA, acc, tid, wm, wn, r, h, st0, pre, AgN, BgN);
  } else {
    if (vt) gemm_kloop_simple<true>(Ag, lda, Bg, ldb, K >> 5, sA, sB, acc, tid, wm, wn, r, h);
    else gemm_kloop_simple<false>(Ag, lda, Bg, ldb, K >> 5, sA, sB, acc, tid, wm, wn, r, h);
  }
  if (Epi::STAGED) __syncthreads();
  float* stg = Epi::CHAIN ? (float*)(smem + st_last * (STG * 2) + wid * 6144) : (float*)smem + wid * 2176;
  if (pm == 0) epi(acc, vt, m0 + wm * 128, n0 + wn * 64, r, h, sR + wm * 128, stg);
  __syncthreads();
  return st_last;
}
template <class Epi>
DI void gemm_phase(const bf16_t* __restrict__ A, int lda, const bf16_t* __restrict__ Bt, int ldb, int Mr, int N, int K, const float* ssq, const Epi& epi,
                   unsigned char* smem, int pm = 0) {
  const int tid = otid();
  const int nM = Mr >> 8, nN = (N + 127) >> 7, ntiles = nM * nN;
  const int band = nM >> 3;
  int st0 = 0; bool pre = false;
  for (int t = blockIdx.x; t < ntiles; t += gridDim.x) {
    const int xcd = t & 7, j = t >> 3;
    const int grp = j / (8 * nN), jj = j % (8 * nN);
    const int tm = xcd * band + grp * 8 + (jj & 7), tn = jj >> 3;
    int tmN = -1, tnN = 0;
    const int tN = t + (int)gridDim.x;
    if (Epi::CHAIN && tN < ntiles) {
      const int xN = tN & 7, jN = tN >> 3, gN = jN / (8 * nN), jjN = jN % (8 * nN);
      tmN = xN * band + gN * 8 + (jjN & 7); tnN = jjN >> 3;
    }
    const int stl = gemm_tile<true>(A, lda, Bt, ldb, K, ssq, tm, tn, epi, smem, pm, st0, pre, tmN, tnN);
    pre = tmN >= 0;
    st0 = stl == 2 ? 0 : stl + 1;
  }
}

DI u32x2 pack4(float a, float b, float c, float d) { u32x2 w; w.x = pack2(a, b); w.y = pack2(c, d); return w; }
DI void flush_rows(const bf16_t* st, bf16_t* dst, int lane) {
#pragma unroll
  for (int j = 0; j < 4; ++j) {
    const int rr = j * 8 + (lane >> 3), cc = (lane & 7) * 8;
    *(u32x4*)(dst + rr * 64 + cc) = *(const u32x4*)(st + rr * 72 + cc);
  }
}
DI void flush_tr(const bf16_t* st, bf16_t* dst, int lane) {
#pragma unroll
  for (int j = 0; j < 4; ++j) {
    const int dd = j * 16 + (lane >> 2), cc = (lane & 3) * 8;
    *(u32x4*)(dst + (size_t)dd * SP + cc) = *(const u32x4*)(st + dd * 40 + cc);
  }
}
struct EpiEvenIn {
  static constexpr bool STAGED = true, CHAIN = true;
  EvenBufs eb; const float* cosT; const float* sinT;
  DI bool vtype(int col0) const { const int seg = col0 >> 6; return seg == 14 || seg == 15 || seg == 18 || seg == 19 || (seg >= 36 && seg < 44); }
  DI void rope(const f32x16 (&acc)[4][2], int row0, int r, int h, const float* sR, bf16_t* dst, int H, int hh, float scale, bf16_t* st) const {
    const int lane = h * 32 + r, b = row0 >> 12, sb = row0 & 4095;
#pragma unroll
    for (int mi = 0; mi < 4; ++mi) {
      const int s = sb + mi * 32 + r;
      const float rv = sR[mi * 32 + r] * scale;
#pragma unroll
      for (int g = 0; g < 4; ++g) {
        const int d0 = 8 * g + 4 * h;
        const f32x4 c = *(const f32x4*)(cosT + s * 32 + d0), sn = *(const f32x4*)(sinT + s * 32 + d0);
        float o1[4], o2[4];
#pragma unroll
        for (int q = 0; q < 4; ++q) {
          const float x1 = acc[mi][0][4 * g + q] * rv, x2 = acc[mi][1][4 * g + q] * rv;
          o1[q] = x1 * c[q] - x2 * sn[q]; o2[q] = x1 * sn[q] + x2 * c[q];
        }
        *(u32x2*)(st + r * 72 + d0) = pack4(o1[0], o1[1], o1[2], o1[3]);
        *(u32x2*)(st + r * 72 + 32 + d0) = pack4(o2[0], o2[1], o2[2], o2[3]);
      }
      flush_rows(st, dst + ((size_t)(b * H + hh) * S + sb + mi * 32) * 64, lane);
    }
  }
  DI void rowmajor(const f32x16 (&acc)[4][2], int row0, int r, int h, const float* sR, bf16_t* dst, int H, int hh, float scale, bf16_t* st) const {
    const int lane = h * 32 + r, b = row0 >> 12, sb = row0 & 4095;
#pragma unroll
    for (int mi = 0; mi < 4; ++mi) {
      const float rv = sR[mi * 32 + r] * scale;
#pragma unroll
      for (int ni = 0; ni < 2; ++ni)
#pragma unroll
        for (int g = 0; g < 4; ++g)
          *(u32x2*)(st + r * 72 + ni * 32 + 8 * g + 4 * h) = pack4(acc[mi][ni][4 * g] * rv, acc[mi][ni][4 * g + 1] * rv, acc[mi][ni][4 * g + 2] * rv, acc[mi][ni][4 * g + 3] * rv);
      flush_rows(st, dst + ((size_t)(b * H + hh) * S + sb + mi * 32) * 64, lane);
    }
  }
  DI void transposed(const f32x16 (&acc)[4][2], int row0, int r, int h, const float* sR, bf16_t* dst, int H, int hh, bf16_t* st) const {
    const int lane = h * 32 + r, b = row0 >> 12, sb = row0 & 4095;
#pragma unroll
    for (int mi = 0; mi < 4; ++mi) {
#pragma unroll
      for (int g = 0; g < 4; ++g) {
        const f32x4 rv = *(const f32x4*)(sR + mi * 32 + 8 * g + 4 * h);
#pragma unroll
        for (int ni = 0; ni < 2; ++ni)
          *(u32x2*)(st + (ni * 32 + r) * 40 + 8 * g + 4 * h) =
              pack4(acc[mi][ni][4 * g] * rv.x, acc[mi][ni][4 * g + 1] * rv.y, acc[mi][ni][4 * g + 2] * rv.z, acc[mi][ni][4 * g + 3] * rv.w);
      }
      flush_tr(st, dst + (size_t)(b * H + hh) * 64 * SP + sb + mi * 32, lane);
    }
  }
  DI void operator()(const f32x16 (&acc)[4][2], bool vt, int row0, int col0, int r, int h, const float* sR, float* stage) const {
    const int seg = col0 >> 6;
    bf16_t* st = (bf16_t*)stage;
    if (seg < 8) rope(acc, row0, r, h, sR, eb.QN, 8, seg, 0.125f, st);
    else if (seg < 10) rope(acc, row0, r, h, sR, eb.KC, 2, seg - 8, 1.f, st);
    else if (seg < 12) rowmajor(acc, row0, r, h, sR, eb.VC, 2, seg - 10, 1.f, st);
    else if (seg < 14) rope(acc, row0, r, h, sR, eb.KS, 2, seg - 12, 1.f, st);
    else if (seg < 16) transposed(acc, row0, r, h, sR, eb.VST, 2, seg - 14, st);
    else if (seg < 18) rope(acc, row0, r, h, sR, eb.KW, 2, seg - 16, 1.f, st);
    else if (seg < 20) transposed(acc, row0, r, h, sR, eb.VWT, 2, seg - 18, st);
    else if (seg < 28) rope(acc, row0, r, h, sR, eb.DQ, 8, seg - 20, 0.125f, st);
    else if (seg < 36) rope(acc, row0, r, h, sR, eb.DK, 8, seg - 28, 1.f, st);
    else if (seg < 44) transposed(acc, row0, r, h, sR, eb.DVT, 8, seg - 36, st);
    else if (seg == 44) {
#pragma unroll
      for (int mi = 0; mi < 4; ++mi) {
        const int row = row0 + mi * 32 + r;
        const float rv = sR[mi * 32 + r];
#pragma unroll
        for (int g = 0; g < 3; ++g) {
          f32x4 o;
#pragma unroll
          for (int q = 0; q < 4; ++q) o[q] = 1.f / (1.f + __expf(-acc[mi][0][4 * g + q] * rv));
          *(f32x4*)(eb.gate + (size_t)row * 24 + 8 * g + 4 * h) = o;
        }
      }
    }
  }
};

struct EpiOddIn {
  static constexpr bool STAGED = true, CHAIN = true;
  bf16_t *Q, *K, *VT;
  DI bool vtype(int col0) const { return col0 >= 2048; }
  DI void operator()(const f32x16 (&acc)[4][2], bool vt, int row0, int col0, int r, int h, const float* sR, float* stage) const {
    const int seg = col0 >> 6, lane = h * 32 + r, b = row0 >> 12, sb = row0 & 4095;
    bf16_t* st = (bf16_t*)stage;
    if (seg < 32) {
      bf16_t* dst = seg < 16 ? Q : K; const int hh = seg & 15; const float sc = seg < 16 ? 0.125f : 1.f;
#pragma unroll
      for (int mi = 0; mi < 4; ++mi) {
        const float rv = sR[mi * 32 + r] * sc;
#pragma unroll
        for (int ni = 0; ni < 2; ++ni)
#pragma unroll
          for (int g = 0; g < 4; ++g)
            *(u32x2*)(st + r * 72 + ni * 32 + 8 * g + 4 * h) = pack4(acc[mi][ni][4 * g] * rv, acc[mi][ni][4 * g + 1] * rv, acc[mi][ni][4 * g + 2] * rv, acc[mi][ni][4 * g + 3] * rv);
        flush_rows(st, dst + ((size_t)(b * 16 + hh) * S + sb + mi * 32) * 64, lane);
      }
    } else {
      const int hh = seg - 32;
#pragma unroll
      for (int mi = 0; mi < 4; ++mi) {
#pragma unroll
        for (int g = 0; g < 4; ++g) {
          const f32x4 rv = *(const f32x4*)(sR + mi * 32 + 8 * g + 4 * h);
#pragma unroll
          for (int ni = 0; ni < 2; ++ni)
            *(u32x2*)(st + (ni * 32 + r) * 40 + 8 * g + 4 * h) =
                pack4(acc[mi][ni][4 * g] * rv.x, acc[mi][ni][4 * g + 1] * rv.y, acc[mi][ni][4 * g + 2] * rv.z, acc[mi][ni][4 * g + 3] * rv.w);
        }
        flush_tr(st, VT + (size_t)(b * 16 + hh) * 64 * SP + sb + mi * 32, lane);
      }
    }
  }
};

struct EpiResid {
  static constexpr bool STAGED = true, CHAIN = false;
  const float* rin; float* out; bf16_t* xb; float* ssq;
  DI bool vtype(int) const { return false; }
  DI void operator()(const f32x16 (&acc)[4][2], bool vt, int row0, int col0, int r, int h, const float* sR, float* stage) const {
    const int lane = h * 32 + r, lr = lane >> 4, lc = (lane & 15) * 4;
#pragma unroll
    for (int mi = 0; mi < 4; ++mi) {
#pragma unroll
      for (int ni = 0; ni < 2; ++ni)
#pragma unroll
        for (int g = 0; g < 4; ++g)
          *(f32x4*)(stage + r * 68 + ni * 32 + 8 * g + 4 * h) = (f32x4){acc[mi][ni][4 * g], acc[mi][ni][4 * g + 1], acc[mi][ni][4 * g + 2], acc[mi][ni][4 * g + 3]};
#pragma unroll
      for (int j = 0; j < 8; ++j) {
        const int rr = j * 4 + lr;
        f32x4 v = *(const f32x4*)(stage + rr * 68 + lc);
        const size_t row = row0 + mi * 32 + rr, idx = row * DM + col0 + lc;
        const f32x4 xin = *(const f32x4*)(rin + idx);
        v += xin;
        *(f32x4*)(out + idx) = v;
        *(u32x2*)(xb + row * LDX + col0 + lc) = pack4(v.x, v.y, v.z, v.w);
        float ss = (v.x * v.x + v.y * v.y) + (v.z * v.z + v.w * v.w);
        ss += __shfl_xor(ss, 1); ss += __shfl_xor(ss, 2); ss += __shfl_xor(ss, 4); ss += __shfl_xor(ss, 8);
        if ((lane & 15) == 0) ssq[row * 16 + (col0 >> 6)] = ss;
      }
    }
  }
};

struct EpiSwiGLU {
  static constexpr bool STAGED = true, CHAIN = true;
  bf16_t* act;
  DI bool vtype(int) const { return false; }
  DI void operator()(const f32x16 (&acc)[4][2], bool vt, int row0, int col0, int r, int h, const float* sR, float* stage) const {
    bf16_t* st = (bf16_t*)stage;
    const int lane = h * 32 + r;
#pragma unroll
    for (int mi = 0; mi < 4; ++mi) {
      const float rv = sR[mi * 32 + r];
#pragma unroll
      for (int g = 0; g < 4; ++g) {
        float o[4];
#pragma unroll
        for (int q = 0; q < 4; ++q) {
          const float gt = acc[mi][0][4 * g + q] * rv, up = acc[mi][1][4 * g + q] * rv;
          o[q] = gt * __builtin_amdgcn_rcpf(1.f + __expf(-gt)) * up;
        }
        *(u32x2*)(st + r * 40 + 8 * g + 4 * h) = pack4(o[0], o[1], o[2], o[3]);
      }
#pragma unroll
      for (int j = 0; j < 2; ++j) {
        const int rr = j * 16 + (lane >> 2), cc = (lane & 3) * 8;
        const u32x4 v = *(const u32x4*)(st + rr * 40 + cc);
        *(u32x4*)(act + (size_t)(row0 + mi * 32 + rr) * LDF + (col0 >> 1) + cc) = v;
      }
    }
  }
};

struct EpiCompress {
  static constexpr bool STAGED = false, CHAIN = false;
  bf16_t* dst; const float* sBias; int tr;
  DI bool vtype(int) const { return tr != 0; }
  DI void operator()(const f32x16 (&acc)[4][2], bool vt, int row0, int col0, int r, int h, const float*, float*) const {
    if (col0 != 0) return;
#pragma unroll
    for (int mi = 0; mi < 4; ++mi) {
      if (tr) {
#pragma unroll
        for (int g = 0; g < 4; ++g) {
          const int R = row0 + mi * 32 + 8 * g + 4 * h, bg = R >> 8, n = R & 255;
#pragma unroll
          for (int ni = 0; ni < 2; ++ni) {
            const float bv = sBias[ni * 32 + r];
            float v[4];
#pragma unroll
            for (int q = 0; q < 4; ++q) v[q] = (n + q == 255) ? 0.f : acc[mi][ni][4 * g + q] + bv;
            *(u32x2*)(dst + ((size_t)bg * 64 + ni * 32 + r) * 256 + n) = pack4(v[0], v[1], v[2], v[3]);
          }
        }
      } else {
        const int R = row0 + mi * 32 + r, bg = R >> 8, n = R & 255;
#pragma unroll
        for (int ni = 0; ni < 2; ++ni)
#pragma unroll
          for (int g = 0; g < 4; ++g) {
            const int d0 = ni * 32 + 8 * g + 4 * h;
            float v[4];
#pragma unroll
            for (int q = 0; q < 4; ++q) v[q] = (n == 255) ? 0.f : acc[mi][ni][4 * g + q] + sBias[d0 + q];
            *(u32x2*)(dst + ((size_t)bg * 256 + n) * 64 + d0) = pack4(v[0], v[1], v[2], v[3]);
          }
      }
    }
  }
};

DI void qk_tile(const bf16_t* sK, const bf16x8 (&qf)[4], f32x16 (&Sx)[2], int r, int h) {
#pragma unroll
  for (int mt = 0; mt < 2; ++mt) {
    f32x16 a;
#pragma unroll
    for (int i = 0; i < 16; ++i) a[i] = 0.f;
#pragma unroll
    for (int s = 0; s < 4; ++s) {
      const bf16x8 k = *(const bf16x8*)(sK + (mt * 32 + r) * 72 + s * 16 + h * 8);
      a = MFMA(k, qf[s], a);
    }
    Sx[mt] = a;
  }
}
template <int NDT> DI void pv_tile(const bf16_t* sV, const f32x16 (&P)[2], f32x16 (&O)[NDT], int r, int h) {
#pragma unroll
  for (int mt = 0; mt < 2; ++mt)
#pragma unroll
    for (int sp = 0; sp < 2; ++sp) {
      u32x4 pk;
      pk.x = pack2(P[mt][8 * sp + 0], P[mt][8 * sp + 1]); pk.y = pack2(P[mt][8 * sp + 2], P[mt][8 * sp + 3]);
      pk.z = pack2(P[mt][8 * sp + 4], P[mt][8 * sp + 5]); pk.w = pack2(P[mt][8 * sp + 6], P[mt][8 * sp + 7]);
      const bf16x8 pb = __builtin_bit_cast(bf16x8, pk);
#pragma unroll
      for (int dt = 0; dt < NDT; ++dt) {
        const bf16_t* vp = sV + (dt * 32 + r) * 68 + mt * 32 + sp * 16 + 4 * h;
        const bf16x4 lo = *(const bf16x4*)vp, hi = *(const bf16x4*)(vp + 8);
        const bf16x8 va = __builtin_shufflevector(lo, hi, 0, 1, 2, 3, 4, 5, 6, 7);
        O[dt] = MFMA(va, pb, O[dt]);
      }
      if (NDT > 2) __builtin_amdgcn_sched_barrier(0);
    }
}
template <bool MASKED>
DI float online_softmax_t(f32x16 (&Sx)[2], unsigned vb, float& m, float& l) {
  float mx = NEG;
#pragma unroll
  for (int mt = 0; mt < 2; ++mt)
#pragma unroll
    for (int i = 0; i < 16; ++i) {
      float s = Sx[mt][i];
      if (MASKED) { s = ((vb >> (mt * 16 + i)) & 1u) ? s : NEG; Sx[mt][i] = s; }
      mx = fmaxf(mx, s);
    }
  mx = fmaxf(mx, shx32(mx));
  const float mn = fmaxf(m, mx);
  const float alpha = __builtin_amdgcn_exp2f((m - mn) * L2E);
  const float mb = mn * L2E;
  f32x2 sum2 = {0.f, 0.f};
  const f32x2 l2e2 = {L2E, L2E}, mb2 = {mb, mb};
#pragma unroll
  for (int mt = 0; mt < 2; ++mt)
#pragma unroll
    for (int i = 0; i < 16; i += 2) {
      const f32x2 t = (f32x2){Sx[mt][i], Sx[mt][i + 1]} * l2e2 - mb2;
      f32x2 p = {__builtin_amdgcn_exp2f(t.x), __builtin_amdgcn_exp2f(t.y)};
      if (MASKED) { p.x = ((vb >> (mt * 16 + i)) & 1u) ? p.x : 0.f; p.y = ((vb >> (mt * 16 + i + 1)) & 1u) ? p.y : 0.f; }
      Sx[mt][i] = p.x; Sx[mt][i + 1] = p.y;
      sum2 += p;
    }
  l = l * alpha + (sum2.x + sum2.y);
  m = mn;
  return alpha;
}
DI float online_softmax(f32x16 (&Sx)[2], unsigned vb, bool masked, float& m, float& l) {
  float alpha;
  if (masked) alpha = online_softmax_t<true>(Sx, vb, m, l);
  else { __builtin_amdgcn_sched_barrier(0); alpha = online_softmax_t<false>(Sx, vb, m, l); __builtin_amdgcn_sched_barrier(0); }
  return alpha;
}
template <int NDT> DI void scale_o(f32x16 (&O)[NDT], float a) {
#pragma unroll
  for (int dt = 0; dt < NDT; ++dt)
#pragma unroll
    for (int i = 0; i < 16; ++i) O[dt][i] *= a;
}
template <int NDT> DI void zero_o(f32x16 (&O)[NDT]) {
#pragma unroll
  for (int dt = 0; dt < NDT; ++dt)
#pragma unroll
    for (int i = 0; i < 16; ++i) O[dt][i] = 0.f;
}
DI void load_q(bf16x8 (&qf)[4], const bf16_t* qrow, int h) {
#pragma unroll
  for (int s = 0; s < 4; ++s) qf[s] = *(const bf16x8*)(qrow + s * 16 + h * 8);
}

DI void diff_pass(const bf16_t* Qrow, const bf16_t* Kg, const bf16_t* VTg, int qt, int q0, int t, f32x16 (&O)[4], float& lsum,
                  bf16_t* sK, bf16_t* sV, int tid, int r, int h) {
  bf16x8 qf[4]; load_q(qf, Qrow, h);
  const int kt_hi = 2 * qt + 1, my_hi = (q0 + 31) >> 6;
  float m = NEG, l = 0.f;
  zero_o<4>(O);
  TR_<2> kr; TR_<4> vr;
  tload(kr, Kg, 64, tid); tload(vr, VTg, SP, tid);
  for (int kt = 0; kt <= kt_hi; ++kt) {
    __syncthreads();
    tstore72(kr, sK, tid); tstore68(vr, sV, tid);
    __syncthreads();
    if (kt < kt_hi) { tload(kr, Kg + (size_t)(kt + 1) * 64 * 64, 64, tid); tload(vr, VTg + (kt + 1) * 64, SP, tid); }
    if (kt <= my_hi) {
      f32x16 Sx[2];
      qk_tile(sK, qf, Sx, r, h);
      const bool masked = (kt * 64 + 63 > q0);
      unsigned vb = 0;
      if (masked) {
#pragma unroll
        for (int mt = 0; mt < 2; ++mt)
#pragma unroll
          for (int i = 0; i < 16; ++i) vb |= (unsigned)(kt * 64 + mt * 32 + crow(i, h) <= t) << (mt * 16 + i);
      }
      const float alpha = online_softmax(Sx, vb, masked, m, l);
      scale_o<4>(O, alpha);
      pv_tile<4>(sV, Sx, O, r, h);
    }
  }
  lsum = l + shx32(l);
}

DI void diff_item(const Params& p_, const EvenBufs& eb_, int e, int b, int hh, int qt, unsigned char* smem) {
  Params p = p_; p.ws = launder(p.ws); p.subln = launder(p.subln);
  const EvenBufs eb = even_bufs(p.ws + OFF_BIG);
  const int tid = otid(), lane = tid & 63, wid = tid >> 6, r = lane & 31, h = lane >> 5;
  bf16_t* sK = (bf16_t*)smem; bf16_t* sV = sK + 64 * 72;
  const int q0 = qt * 128 + wid * 32, t = q0 + r;
  const bf16_t* VTg = eb.DVT + (size_t)(b * 4 + hh) * 128 * SP;
  f32x16 O[4]; float l1, l2;
  diff_pass(eb.DQ + ((size_t)(b * 8 + hh * 2) * S + t) * 64, eb.DK + (size_t)(b * 8 + hh * 2) * S * 64, VTg, qt, q0, t, O, l1, sK, sV, tid, r, h);
  unsigned* o1s = (unsigned*)(smem + 40960) + tid;
  {
    const float inv = 1.f / l1;
#pragma unroll
    for (int dt = 0; dt < 4; ++dt)
#pragma unroll
      for (int i = 0; i < 8; ++i) o1s[(dt * 8 + i) * 256] = pack2(O[dt][2 * i] * inv, O[dt][2 * i + 1] * inv);
  }
  diff_pass(eb.DQ + ((size_t)(b * 8 + hh * 2 + 1) * S + t) * 64, eb.DK + (size_t)(b * 8 + hh * 2 + 1) * S * 64, VTg, qt, q0, t, O, l2, sK, sV, tid, r, h);
  int e2 = e; asm volatile("" : "+s"(e2));
  const float lam = ((const float*)(p.ws + OFF_CBIAS + 2048))[e2];
  const float lam_init = 0.8f - 0.6f * __expf(-0.3f * (float)(2 * e2));
  const float c2 = lam / l2;
  float ss = 0.f;
#pragma unroll
  for (int dt = 0; dt < 4; ++dt)
#pragma unroll
    for (int i = 0; i < 8; ++i) {
      const unsigned ov = o1s[(dt * 8 + i) * 256];
      const float a0 = __uint_as_float(ov << 16), a1 = __uint_as_float(ov & 0xffff0000u);
      const float v0 = a0 - c2 * O[dt][2 * i], v1 = a1 - c2 * O[dt][2 * i + 1];
      O[dt][2 * i] = v0; O[dt][2 * i + 1] = v1;
      ss += v0 * v0 + v1 * v1;
    }
  ss += shx32(ss);
  const float rinv = rsqrtf(ss * (1.f / 128.f) + 1e-6f) * (1.f - lam_init);
  const float* sub = p.subln + e * 128;
  bf16_t* orow = (bf16_t*)(p.ws + OFF_HB) + (size_t)(b * S + t) * LDX + 512 + hh * 128;
#pragma unroll
  for (int dt = 0; dt < 4; ++dt)
#pragma unroll
    for (int g = 0; g < 4; ++g) {
      __builtin_amdgcn_sched_barrier(0);
      const int d = dt * 32 + 8 * g + 4 * h;
      const f32x4 sg = *(const f32x4*)(sub + d);
      u32x2 w;
      w.x = pack2(O[dt][4 * g] * rinv * sg.x, O[dt][4 * g + 1] * rinv * sg.y);
      w.y = pack2(O[dt][4 * g + 2] * rinv * sg.z, O[dt][4 * g + 3] * rinv * sg.w);
      *(u32x2*)(orow + d) = w;
    }
}

DI void nsa_item(const Params& p_, const EvenBufs& eb_, int b, int g, int tt, unsigned char* smem) {
  Params p = p_; p.ws = launder(p.ws);
  const EvenBufs eb = even_bufs(p.ws + OFF_BIG);
  const int tid = otid(), lane = tid & 63, wid = tid >> 6, r = lane & 31, h = lane >> 5;
  bf16_t* sK = (bf16_t*)smem; bf16_t* sV = sK + 64 * 72;
  float* impW = (float*)(smem + 18432);
  u64* selm = (u64*)(smem + 18432 + 32768);
  const int t0 = tt * 32, t = t0 + r, head = g * 4 + wid, bg = b * 2 + g;
  bf16x8 qf[4]; load_q(qf, eb.QN + ((size_t)(b * 8 + head) * S + t) * 64, h);
  const float* gp = eb.gate + (size_t)(b * S + t) * 24 + head * 3;
  const float g0 = gp[0], g1 = gp[1], g2 = gp[2];
  f32x16 acc[2], O[2];

  const int nct = (t0 >> 10) + 1, nlim = (t - 31) >> 4;
  const bf16_t* Kc = eb.KCMP + (size_t)bg * 256 * 64;
  const bf16_t* VcT = eb.VCMPT + (size_t)bg * 64 * 256;
  float m = NEG, l = 0.f;
  for (int kt = 0; kt < nct; ++kt) {
    TR_<2> kr; tload(kr, Kc + kt * 64 * 64, 64, tid);
    __syncthreads();
    tstore72(kr, sK, tid);
    __syncthreads();
    f32x16 Sx[2]; qk_tile(sK, qf, Sx, r, h);
    unsigned vb = 0;
#pragma unroll
    for (int mt = 0; mt < 2; ++mt)
#pragma unroll
      for (int i = 0; i < 16; ++i) vb |= (unsigned)(kt * 64 + mt * 32 + crow(i, h) <= nlim) << (mt * 16 + i);
    online_softmax_t<true>(Sx, vb, m, l);
  }
  l += shx32(l);
  const float invl = l > 0.f ? 1.f / l : 0.f;
  const float mb = m * L2E;
  zero_o<2>(O);
  float carry_prev = 0.f;
  for (int kt = 0; kt < nct; ++kt) {
    TR_<2> kr, vr; tload(kr, Kc + kt * 64 * 64, 64, tid); tload(vr, VcT + kt * 64, 256, tid);
    __syncthreads();
    tstore72(kr, sK, tid); tstore68(vr, sV, tid);
    __syncthreads();
    f32x16 Sx[2]; qk_tile(sK, qf, Sx, r, h);
#pragma unroll
    for (int mt = 0; mt < 2; ++mt) {
#pragma unroll
      for (int i = 0; i < 16; ++i) {
        const bool ok = (kt * 64 + mt * 32 + crow(i, h)) <= nlim;
        const float pr = __builtin_amdgcn_exp2f(Sx[mt][i] * L2E - mb) * invl;
        Sx[mt][i] = ok ? pr : 0.f;
      }
      float x[4];
#pragma unroll
      for (int gg = 0; gg < 4; ++gg) x[gg] = shx32(Sx[mt][4 * gg + 3]);
#pragma unroll
      for (int gg = 0; gg < 4; ++gg) {
        const float prev = h ? x[gg] : (gg ? x[gg > 0 ? gg - 1 : 0] : carry_prev);
        const float val = Sx[mt][4 * gg] + Sx[mt][4 * gg + 1] + Sx[mt][4 * gg + 2] + Sx[mt][4 * gg + 3] + prev;
        impW[(wid * 32 + r) * 64 + kt * 16 + mt * 8 + 2 * gg + h] = val;
      }
      carry_prev = x[3];
    }
    pv_tile<2>(sV, Sx, O, r, h);
  }
#pragma unroll
  for (int dt = 0; dt < 2; ++dt)
#pragma unroll
    for (int i = 0; i < 16; ++i) acc[dt][i] = g0 * O[dt][i];
  __syncthreads();
  for (int q = 0; q < 8; ++q) {
    const int rr = wid * 8 + q, tq = t0 + rr, qb = tq >> 6;
    float v = 0.f;
    if (lane < nct * 16) v = impW[(0 * 32 + rr) * 64 + lane] + impW[(1 * 32 + rr) * 64 + lane] + impW[(2 * 32 + rr) * 64 + lane] + impW[(3 * 32 + rr) * 64 + lane];
    const bool forced = (lane == 0) || (lane == qb) || (lane == qb - 1);
    v = forced ? 1e30f : ((lane > qb) ? -1e30f : v);
    int rank = 0;
#pragma unroll
    for (int jj = 0; jj < 64; ++jj) {
      const float o = __builtin_bit_cast(float, __builtin_amdgcn_readlane(__builtin_bit_cast(int, v), jj));
      rank += ((o > v) || (o == v && jj < lane)) ? 1 : 0;
    }
    const bool sel = (rank < 16) && (v >= 0.f);
    const u64 mk = __ballot(sel);
    if (lane == 0) selm[rr] = mk;
  }
  __syncthreads();
  const u64 mysel = selm[r];
  u64 un;
  {
    unsigned lo = (unsigned)mysel, hi = (unsigned)(mysel >> 32);
#pragma unroll
    for (int o = 1; o < 32; o <<= 1) { lo |= (unsigned)__shfl_xor((int)lo, o); hi |= (unsigned)__shfl_xor((int)hi, o); }
    un = ((u64)hi << 32) | lo;
    un = ((u64)(unsigned)__builtin_amdgcn_readfirstlane((int)hi) << 32) | (unsigned)__builtin_amdgcn_readfirstlane((int)lo);
  }
  {
    const bf16_t* Kg = eb.KS + (size_t)bg * S * 64;
    const bf16_t* VTg = eb.VST + (size_t)bg * 64 * SP;
    m = NEG; l = 0.f; zero_o<2>(O);
    u64 rem = un;
    int j = __builtin_ctzll(rem); rem &= rem - 1;
    TR_<2> kr, vr; tload(kr, Kg + (size_t)j * 64 * 64, 64, tid); tload(vr, VTg + j * 64, SP, tid);
    while (true) {
      __syncthreads();
      tstore72(kr, sK, tid); tstore68(vr, sV, tid);
      __syncthreads();
      int jn = -1;
      if (rem) { jn = __builtin_ctzll(rem); rem &= rem - 1; tload(kr, Kg + (size_t)jn * 64 * 64, 64, tid); tload(vr, VTg + jn * 64, SP, tid); }
      f32x16 Sx[2]; qk_tile(sK, qf, Sx, r, h);
      const bool sb = (mysel >> j) & 1ull;
      unsigned vb = sb ? 0xffffffffu : 0u;
      bool masked = (__ballot(sb) != ~0ull);
      if (j == (t0 >> 6)) {
        masked = true; vb = 0;
#pragma unroll
        for (int mt = 0; mt < 2; ++mt)
#pragma unroll
          for (int i = 0; i < 16; ++i) vb |= (unsigned)(sb && (j * 64 + mt * 32 + crow(i, h) <= t)) << (mt * 16 + i);
      }
      if (!masked) vb = 0xffffffffu;
      const float alpha = online_softmax_t<true>(Sx, vb, m, l);
      scale_o<2>(O, alpha);
      pv_tile<2>(sV, Sx, O, r, h);
      if (jn < 0) break;
      j = jn;
    }
    l += shx32(l);
    const float c = g1 / l;
#pragma unroll
    for (int dt = 0; dt < 2; ++dt)
#pragma unroll
      for (int i = 0; i < 16; ++i) acc[dt][i] += c * O[dt][i];
  }
  {
    const bf16_t* Kg = eb.KW + (size_t)bg * S * 64;
    const bf16_t* VTg = eb.VWT + (size_t)bg * 64 * SP;
    m = NEG; l = 0.f; zero_o<2>(O);
    const int lo0 = t0 - 511;
    const int kt_lo = (lo0 > 0 ? lo0 : 0) >> 6, kt_hi = t0 >> 6;
    TR_<2> kr, vr; tload(kr, Kg + (size_t)kt_lo * 64 * 64, 64, tid); tload(vr, VTg + kt_lo * 64, SP, tid);
    for (int kt = kt_lo; kt <= kt_hi; ++kt) {
      __syncthreads();
      tstore72(kr, sK, tid); tstore68(vr, sV, tid);
      __syncthreads();
      if (kt < kt_hi) { tload(kr, Kg + (size_t)(kt + 1) * 64 * 64, 64, tid); tload(vr, VTg + (kt + 1) * 64, SP, tid); }
      f32x16 Sx[2]; qk_tile(sK, qf, Sx, r, h);
      const bool masked = !((kt * 64 + 63 <= t0) && (kt * 64 > t0 + 31 - 512));
      unsigned vb = 0;
      if (masked) {
#pragma unroll
        for (int mt = 0; mt < 2; ++mt)
#pragma unroll
          for (int i = 0; i < 16; ++i) {
            const int key = kt * 64 + mt * 32 + crow(i, h);
            vb |= (unsigned)((key <= t) && (key > t - 512)) << (mt * 16 + i);
          }
      }
      if (!masked) vb = 0xffffffffu;
      const float alpha = online_softmax_t<true>(Sx, vb, m, l);
      scale_o<2>(O, alpha);
      pv_tile<2>(sV, Sx, O, r, h);
    }
    l += shx32(l);
    const float c = g2 / l;
#pragma unroll
    for (int dt = 0; dt < 2; ++dt)
#pragma unroll
      for (int i = 0; i < 16; ++i) acc[dt][i] += c * O[dt][i];
  }
  bf16_t* orow = (bf16_t*)(p.ws + OFF_HB) + (size_t)(b * S + t) * LDX + head * 64;
#pragma unroll
  for (int dt = 0; dt < 2; ++dt)
#pragma unroll
    for (int gg = 0; gg < 4; ++gg) {
      u32x2 w; w.x = pack2(acc[dt][4 * gg], acc[dt][4 * gg + 1]); w.y = pack2(acc[dt][4 * gg + 2], acc[dt][4 * gg + 3]);
      *(u32x2*)(orow + dt * 32 + 8 * gg + 4 * h) = w;
    }
}

template <bool MASKED>
DI void sb_weights(f32x16 (&Sx)[2], float& carry, int kt, int t, int h) {
#pragma unroll
      for (int mt = 1; mt >= 0; --mt) {
        float L[16];
#pragma unroll
        for (int i = 0; i < 16; ++i) {
          const float z = Sx[mt][i];
          const bool ok = !MASKED || (kt * 64 + mt * 32 + crow(i, h) < t);
          const float sp = fmaxf(z, 0.f) + __logf(1.f + __expf(-fabsf(z)));
          L[i] = ok ? -sp : 0.f;
          Sx[mt][i] = ok ? (z - sp) : NEG;
        }
        float G[4], Go[4];
#pragma unroll
        for (int gg = 0; gg < 4; ++gg) { G[gg] = (L[4 * gg] + L[4 * gg + 1]) + (L[4 * gg + 2] + L[4 * gg + 3]); Go[gg] = shx32(G[gg]); }
        float T[4];
        T[3] = 0.f; T[2] = G[3] + Go[3]; T[1] = T[2] + (G[2] + Go[2]); T[0] = T[1] + (G[1] + Go[1]);
        const float tot = T[0] + (G[0] + Go[0]);
#pragma unroll
        for (int gg = 0; gg < 4; ++gg) {
          const float s3 = carry + T[gg] + (h ? 0.f : Go[gg]);
          const float s2 = s3 + L[4 * gg + 3], s1 = s2 + L[4 * gg + 2], s0 = s1 + L[4 * gg + 1];
          Sx[mt][4 * gg + 3] = __expf(Sx[mt][4 * gg + 3] + s3);
          Sx[mt][4 * gg + 2] = __expf(Sx[mt][4 * gg + 2] + s2);
          Sx[mt][4 * gg + 1] = __expf(Sx[mt][4 * gg + 1] + s1);
          Sx[mt][4 * gg + 0] = __expf(Sx[mt][4 * gg + 0] + s0);
        }
        carry += tot;
      }
}

DI void sb_item(const Params& p_, int b, int hh, int qt, unsigned char* smem) {
  Params p = p_; p.ws = launder(p.ws);
  const int tid = otid(), lane = tid & 63, wid = tid >> 6, r = lane & 31, h = lane >> 5;
  bf16_t* sK = (bf16_t*)smem; bf16_t* sV = sK + 64 * 72;
  unsigned char* big = p.ws + OFF_BIG;
  const bf16_t* Qb = (const bf16_t*)big; const bf16_t* Kb = (const bf16_t*)(big + 32 * MiB); const bf16_t* VTb = (const bf16_t*)(big + 64 * MiB);
  const int q0 = qt * 128 + wid * 32, t = q0 + r;
  bf16x8 qf[4]; load_q(qf, Qb + ((size_t)(b * 16 + hh) * S + t) * 64, h);
  const bf16_t* Kg = Kb + (size_t)(b * 16 + hh) * S * 64;
  const bf16_t* VTg = VTb + (size_t)(b * 16 + hh) * 64 * SP;
  const int kt_hi = 2 * qt + 1, my_hi = (q0 + 31) >> 6;
  f32x16 O[2]; zero_o<2>(O);
  float carry = 0.f;
  TR_<2> kr, vr; tload(kr, Kg + (size_t)kt_hi * 64 * 64, 64, tid); tload(vr, VTg + kt_hi * 64, SP, tid);
  __syncthreads();
  for (int kt = kt_hi; kt >= 0; --kt) {
    tstore72(kr, sK, tid); tstore68(vr, sV, tid);
    __syncthreads();
    if (kt > 0) { tload(kr, Kg + (size_t)(kt - 1) * 64 * 64, 64, tid); tload(vr, VTg + (kt - 1) * 64, SP, tid); }
    if (kt <= my_hi) {
      f32x16 Sx[2]; qk_tile(sK, qf, Sx, r, h);
      if (kt * 64 + 63 >= q0) sb_weights<true>(Sx, carry, kt, t, h);
      else { __builtin_amdgcn_sched_barrier(0); sb_weights<false>(Sx, carry, kt, t, h); __builtin_amdgcn_sched_barrier(0); }
      pv_tile<2>(sV, Sx, O, r, h);
    }
#if SB_EARLY
    {
      volatile int* flg = (volatile int*)(smem + 18432) + (kt & 1) * 4;
      const bool wall = (__ballot(carry < -104.f) == ~0ull);
      if (lane == 0) flg[wid] = wall ? 1 : 0;
      __syncthreads();
      if (flg[0] & flg[1] & flg[2] & flg[3]) break;
    }
#else
    __syncthreads();
#endif
  }
  bf16_t* orow = (bf16_t*)(p.ws + OFF_HB) + (size_t)(b * S + t) * LDX + hh * 64;
#pragma unroll
  for (int dt = 0; dt < 2; ++dt)
#pragma unroll
    for (int gg = 0; gg < 4; ++gg) {
      u32x2 w; w.x = pack2(O[dt][4 * gg], O[dt][4 * gg + 1]); w.y = pack2(O[dt][4 * gg + 2], O[dt][4 * gg + 3]);
      *(u32x2*)(orow + dt * 32 + 8 * gg + 4 * h) = w;
    }
}

DI void final_phase(float* xio, const float* g) {
  const int tidx = otid(), lane = tidx & 63, gw = blockIdx.x * 4 + (tidx >> 6), nw = gridDim.x * 4;
  for (int row = gw; row < M; row += nw) {
    float* xr = xio + (size_t)row * DM;
    f32x4 v[4]; float ss = 0.f;
#pragma unroll
    for (int i = 0; i < 4; ++i) { v[i] = *(const f32x4*)(xr + (i * 64 + lane) * 4); ss += v[i].x * v[i].x + v[i].y * v[i].y + v[i].z * v[i].z + v[i].w * v[i].w; }
#pragma unroll
    for (int o = 1; o < 64; o <<= 1) ss += __shfl_xor(ss, o);
    const float rinv = rsqrtf(ss * (1.f / DM) + 1e-6f);
#pragma unroll
    for (int i = 0; i < 4; ++i) {
      const f32x4 gg = *(const f32x4*)(g + (i * 64 + lane) * 4);
      f32x4 o; o.x = v[i].x * rinv * gg.x; o.y = v[i].y * rinv * gg.y; o.z = v[i].z * rinv * gg.z; o.w = v[i].w * rinv * gg.w;
      *(f32x4*)(xr + (i * 64 + lane) * 4) = o;
    }
  }
}
DI void xprep_phase(const float* xin, bf16_t* xb, float* ssq) {
  const int tidx = otid(), lane = tidx & 63, gw = blockIdx.x * 4 + (tidx >> 6), nw = gridDim.x * 4;
  for (int row = gw; row < M; row += nw) {
    const float* xr = xin + (size_t)row * DM;
    f32x4 v[4]; float ss = 0.f;
#pragma unroll
    for (int i = 0; i < 4; ++i) { v[i] = *(const f32x4*)(xr + (i * 64 + lane) * 4); ss += v[i].x * v[i].x + v[i].y * v[i].y + v[i].z * v[i].z + v[i].w * v[i].w; }
#pragma unroll
    for (int o = 1; o < 64; o <<= 1) ss += __shfl_xor(ss, o);
#pragma unroll
    for (int i = 0; i < 4; ++i) *(u32x2*)(xb + (size_t)row * LDX + (i * 64 + lane) * 4) = pack4(v[i].x, v[i].y, v[i].z, v[i].w);
    if (lane < 16) ssq[(size_t)row * 16 + lane] = lane == 0 ? ss : 0.f;
  }
}

struct TJob { const float* src; bf16_t* dst; const float* ks; int K, N, mode, ldd; };
DI TJob get_job(const Params& p, int j) {
  TJob t; t.ks = nullptr; t.ldd = LDX;
  unsigned char* ws = p.ws;
  if (j < 2) { t.src = p.even_w_in + (size_t)j * 1024 * 2840; t.dst = (bf16_t*)(ws + OFF_WEI) + (size_t)j * EN * LDX; t.K = 1024; t.N = 2840; t.mode = 1; t.ks = p.norm_mix + (2 * j) * DM; }
  else if (j < 4) { int e = j - 2; t.src = p.even_w_out + (size_t)e * 1024 * 1024; t.dst = (bf16_t*)(ws + OFF_WEO) + (size_t)e * 1024 * LDX; t.K = 1024; t.N = 1024; t.mode = 0; }
  else if (j < 6) { int e = j - 4; t.src = p.odd_w_in + (size_t)e * 1024 * 3072; t.dst = (bf16_t*)(ws + OFF_WOI) + (size_t)e * 3072 * LDX; t.K = 1024; t.N = 3072; t.mode = 0; t.ks = p.norm_mix + (2 * e + 1) * DM; }
  else if (j < 8) { int e = j - 6; t.src = p.odd_w_out + (size_t)e * 1024 * 1024; t.dst = (bf16_t*)(ws + OFF_WOO) + (size_t)e * 1024 * LDX; t.K = 1024; t.N = 1024; t.mode = 0; }
  else if (j < 10) { int e = j - 8; t.src = p.cmp_w_k + (size_t)e * 2048 * 64; t.dst = (bf16_t*)(ws + OFF_CMPW) + (size_t)(e * 2 + 0) * 128 * 2048; t.K = 2048; t.N = 64; t.mode = 0; t.ldd = 2048; }
  else { int e = j - 10; t.src = p.cmp_w_v + (size_t)e * 2048 * 64; t.dst = (bf16_t*)(ws + OFF_CMPW) + (size_t)(e * 2 + 1) * 128 * 2048; t.K = 2048; t.N = 64; t.mode = 0; t.ldd = 2048; }
  return t;
}
DI TJob ffn_job(const Params& p, int layer, int j) {
  TJob t; t.ks = nullptr; t.ldd = LDX;
  if (j == 0) { t.src = p.w_gate + (size_t)layer * 1024 * FH; t.dst = (bf16_t*)(p.ws + OFF_WGU); t.K = 1024; t.N = FH; t.mode = 2; t.ks = p.norm_ffn + layer * DM; }
  else if (j == 1) { t.src = p.w_up + (size_t)layer * 1024 * FH; t.dst = (bf16_t*)(p.ws + OFF_WGU); t.K = 1024; t.N = FH; t.mode = 3; t.ks = p.norm_ffn + layer * DM; }
  else { t.src = p.w_down + (size_t)layer * FH * 1024; t.dst = (bf16_t*)(p.ws + OFF_WDN); t.K = FH; t.N = 1024; t.mode = 0; t.ldd = LDF; }
  return t;
}
DI TJob layer_job(const Params& p, int layer, int j) {
  if (j < 3) return ffn_job(p, layer, j);
  if (j == 3) return get_job(p, (layer & 1) ? 6 + (layer >> 1) : 2 + (layer >> 1));
  return get_job(p, (layer & 1) ? 1 : 4 + (layer >> 1));
}
DI int layer_job_tiles(int layer, int j) { return j < 3 ? 704 : (j == 3 ? 256 : ((layer & 1) ? 720 : 768)); }
DI int layer_conv_items(int layer) { return layer == 3 ? 592 : ((layer & 1) ? 772 : 784); }
DI int map_col(int n, int mode) {
  if (mode == 0) return n;
  if (mode == 1) return n < 1280 ? n : (n < 1304 ? 2816 + (n - 1280) : n - 24);
  if (mode == 2) return (n >> 5) * 64 + (n & 31);
  return (n >> 5) * 64 + 32 + (n & 31);
}
DI void transpose_tile(const TJob& t, int lt, unsigned char* smem, int tid) {
  float* tl = (float*)smem;
  const int nkt = t.K >> 6, k0 = (lt % nkt) << 6, n0 = (lt / nkt) << 6;
  f32x4 v[4];
#pragma unroll
  for (int i = 0; i < 4; ++i) {
    const int k = i * 16 + (tid >> 4), n = (tid & 15) * 4;
    v[i] = (n0 + n < t.N) ? *(const f32x4*)(t.src + (size_t)(k0 + k) * t.N + n0 + n) : (f32x4){0.f, 0.f, 0.f, 0.f};
  }
#pragma unroll
  for (int i = 0; i < 4; ++i) {
    const int k = i * 16 + (tid >> 4), n = (tid & 15) * 4;
    const float sc = t.ks ? t.ks[k0 + k] : 1.f;
    tl[k * 65 + n] = v[i].x * sc; tl[k * 65 + n + 1] = v[i].y * sc; tl[k * 65 + n + 2] = v[i].z * sc; tl[k * 65 + n + 3] = v[i].w * sc;
  }
  __syncthreads();
#pragma unroll
  for (int i = 0; i < 8; ++i) {
    const int n = i * 8 + (tid >> 5), k2 = (tid & 31) * 2;
    if (n0 + n < t.N) *(unsigned*)(t.dst + (size_t)map_col(n0 + n, t.mode) * t.ldd + k0 + k2) = pack2(tl[k2 * 65 + n], tl[(k2 + 1) * 65 + n]);
  }
  __syncthreads();
}
DI void prep_phase(const Params& p, unsigned char* smem) {
  const int tid = otid();
  for (int tile = blockIdx.x; tile < 720 + 4 * 32; tile += gridDim.x) {
    const int j = tile < 720 ? 0 : 8 + (tile - 720) / 32, lt = tile < 720 ? tile : (tile - 720) % 32;
    const TJob t = get_job(p, j);
    transpose_tile(t, lt, smem, tid);
  }
  {
    const int gt = blockIdx.x * 256 + tid, nt = gridDim.x * 256;
    for (int i = gt; i < 2 * 104 * (LDX / 2); i += nt) {
      const int e = i / (104 * (LDX / 2)), rem = i % (104 * (LDX / 2));
      ((unsigned*)((bf16_t*)(p.ws + OFF_WEI) + (size_t)e * EN * LDX + (size_t)2840 * LDX))[rem] = 0u;
    }
    float* cosT = (float*)(p.ws + OFF_COS); float* sinT = (float*)(p.ws + OFF_SIN);
    for (int i = gt; i < S * 32; i += nt) {
      const int s = i >> 5, d = i & 31;
      const float inv = 1.0f / powf(10000.0f, (float)(2 * d) / 64.0f);
      const float ang = (float)s * inv;
      cosT[i] = cosf(ang); sinT[i] = sinf(ang);
    }
  }
  const int nb = gridDim.x;
  for (int jc = blockIdx.x; jc < 128; jc += nb) {
    const int j = jc >> 5, c = jc & 31, e = j >> 1, kv = j & 1, w = tid >> 6, d = tid & 63;
    const float* pos = (kv ? p.cmp_pos_v : p.cmp_pos_k) + (size_t)e * 2048 + c * 64 + w * 16;
    const float* wt = (kv ? p.cmp_w_v : p.cmp_w_k) + ((size_t)e * 2048 + c * 64 + w * 16) * 64 + d;
    float s = 0.f;
#pragma unroll
    for (int k = 0; k < 16; ++k) s += pos[k] * wt[(size_t)k * 64];
    float* red = (float*)smem;
    __syncthreads();
    red[tid] = s;
    __syncthreads();
    if (tid < 64) ((float*)(p.ws + OFF_CPART))[(j * 32 + c) * 64 + tid] = (red[tid] + red[64 + tid]) + (red[128 + tid] + red[192 + tid]);
  }
  if (blockIdx.x == (128 % nb) && tid < 2) {
    const int e = tid;
    float s1 = 0.f, s2 = 0.f;
    for (int k = 0; k < 64; ++k) { s1 += p.lq1[e * 64 + k] * p.lk1[e * 64 + k]; s2 += p.lq2[e * 64 + k] * p.lk2[e * 64 + k]; }
    const float lam_init = 0.8f - 0.6f * expf(-0.3f * (float)(2 * e));
    ((float*)(p.ws + OFF_CBIAS + 2048))[e] = expf(s1) - expf(s2) + lam_init;
  }
  xprep_phase(p.x, (bf16_t*)(p.ws + OFF_XB), (float*)(p.ws + OFF_SSQ));
}

DI int fetch_item(unsigned* ctr, int* s_item) {
  __syncthreads();
  if (threadIdx.x == 0) *s_item = (int)atomicAdd(ctr, 1u);
  __syncthreads();
  return *s_item;
}
DI void ffn_conv_item(const Params& p_, int layer, int it, unsigned char* smem) {
  Params p = p_; p.ws = launder(p.ws); p.w_gate = launder(p.w_gate); p.w_up = launder(p.w_up); p.w_down = launder(p.w_down); p.norm_ffn = launder(p.norm_ffn);
  p.even_w_in = launder(p.even_w_in); p.even_w_out = launder(p.even_w_out); p.odd_w_in = launder(p.odd_w_in); p.odd_w_out = launder(p.odd_w_out); p.norm_mix = launder(p.norm_mix);
  const int tid = otid();
  for (int q = 0; q < 4; ++q) {
    int lt = it * 4 + q, j = 0;
    while (lt >= layer_job_tiles(layer, j)) { lt -= layer_job_tiles(layer, j); ++j; }
    const TJob t = layer_job(p, layer, j);
    transpose_tile(t, lt, smem, tid);
  }
}
DI void compress_item(const Params& p_, const EvenBufs& eb_, int e, int it, unsigned* done, unsigned char* smem) {
  const int tid = otid();
  Params p = p_; p.ws = launder(p.ws);
  const EvenBufs eb = even_bufs(p.ws + OFF_BIG);
  const int kv = it >> 3, tm = it & 7;
  float* sBias = (float*)(smem + 73728);
  if (tid < 64) {
    const float* part = (const float*)(p.ws + OFF_CPART) + (size_t)(e * 2 + kv) * 32 * 64 + tid;
    float s = 0.f;
    for (int c = 0; c < 32; ++c) s += part[c * 64];
    sBias[tid] = s;
  }
  __syncthreads();
  EpiCompress ep; ep.dst = kv ? eb.VCMPT : eb.KCMP; ep.sBias = sBias; ep.tr = kv;
  gemm_tile<true>(kv ? eb.VC : eb.KC, 1024, (const bf16_t*)(p.ws + OFF_CMPW) + (size_t)(e * 2 + kv) * 128 * 2048, 2048, 2048, nullptr, tm, 0, ep, smem, 0);
  asm volatile("s_waitcnt vmcnt(0)" ::: "memory");
  __syncthreads();
  if (tid == 0) __hip_atomic_fetch_add(done, 1u, __ATOMIC_RELEASE, __HIP_MEMORY_SCOPE_AGENT);
}
DI void wait_count(unsigned* ctr, unsigned target) {
  if (threadIdx.x == 0) {
    while (__hip_atomic_load(ctr, __ATOMIC_RELAXED, __HIP_MEMORY_SCOPE_AGENT) < target) __builtin_amdgcn_s_sleep(8);
    __builtin_amdgcn_fence(__ATOMIC_ACQUIRE, "agent");
    asm volatile("s_waitcnt vmcnt(0)" ::: "memory");
  }
  __syncthreads();
}


#define XB_TMO      128
#define XB_XCNT(j)  (256  + 64 * (j))
#define XB_XSUB(j)  (1280 + 64 * (j))
#define XB_XGEN(j)  (2304 + 64 * (j))
#define XB_TOP      3328
#define XB_TOPGEN   3392
#define XCD_BAR_WORDS 3456
#define XB_SPIN_CAP (1u << 18)
#define LAS __attribute__((address_space(3)))
DI unsigned xb_ld(unsigned* p) { return __hip_atomic_load(p, __ATOMIC_RELAXED, __HIP_MEMORY_SCOPE_AGENT); }
DI unsigned xb_add(unsigned* p, unsigned v) { return __hip_atomic_fetch_add(p, v, __ATOMIC_RELAXED, __HIP_MEMORY_SCOPE_AGENT); }
DI unsigned xb_xcc_id() { return (unsigned)__builtin_amdgcn_s_getreg((3 << 11) | 20) & 0xFu; }
#define XB_SPIN(cond, bar) do { unsigned _sp = 0; while (cond) { __builtin_amdgcn_s_sleep(1); \
    if ((++_sp & 255u) == 0u) { if (xb_ld(&(bar)[XB_TMO])) break; if (_sp > XB_SPIN_CAP) { atomicAdd(&(bar)[XB_TMO], 1u); break; } } } } while (0)
struct XcdBarrier { unsigned* bar; unsigned x; volatile LAS unsigned* st; };
DI XcdBarrier xcd_barrier_post(unsigned* bar, volatile LAS unsigned* st) {
  XcdBarrier b; b.bar = bar; b.x = xb_xcc_id(); b.st = st;
  if (threadIdx.x == 0) (void)xb_add(&bar[XB_XCNT(b.x)], 1u);
  return b;
}
DI void xcd_barrier_complete(unsigned* bar, unsigned x, unsigned& nloc, unsigned& nx) {
  const unsigned G = gridDim.x * gridDim.y * gridDim.z;
  unsigned sum, cnt, mine, sp = 0u;
  for (;;) {
    sum = 0u; cnt = 0u; mine = 0u;
#pragma unroll
    for (unsigned j = 0; j < 16; ++j) { const unsigned c = xb_ld(&bar[XB_XCNT(j)]); sum += c; cnt += (c > 0u) ? 1u : 0u; mine = (j == x) ? c : mine; }
    if (sum == G) break;
    __builtin_amdgcn_s_sleep(1);
    if ((++sp & 255u) == 0u) { if (xb_ld(&bar[XB_TMO])) break; if (sp > XB_SPIN_CAP) { atomicAdd(&bar[XB_TMO], 1u); break; } }
  }
  nloc = mine > 0u ? mine : 1u; nx = cnt > 0u ? cnt : 1u;
}
DI void xcd_barrier(const XcdBarrier& b_) {
  XcdBarrier b = b_; b.x = xb_xcc_id(); b.bar = launder(b.bar);
  asm volatile("s_waitcnt vmcnt(0)" ::: "memory");
  __syncthreads();
  if (threadIdx.x == 0) {
    unsigned* bar = b.bar;
    __builtin_amdgcn_s_waitcnt(0);
    unsigned nloc = b.st[0], nx = b.st[1];
    if (nloc == 0u) { xcd_barrier_complete(bar, b.x, nloc, nx); b.st[0] = nloc; b.st[1] = nx; }
    const unsigned old = xb_add(&bar[XB_XSUB(b.x)], 1u);
    const unsigned gen = old / nloc;
    if (old + 1u == (gen + 1u) * nloc) {
      __builtin_amdgcn_fence(__ATOMIC_RELEASE, "agent");
      asm volatile("s_waitcnt vmcnt(0)" ::: "memory");
      const unsigned og = xb_add(&bar[XB_TOP], 1u);
      const unsigned tg = og / nx;
      if (og + 1u == (tg + 1u) * nx) xb_add(&bar[XB_TOPGEN], 1u);
      else XB_SPIN(xb_ld(&bar[XB_TOPGEN]) == tg, bar);
      __builtin_amdgcn_fence(__ATOMIC_ACQUIRE, "agent");
      xb_add(&bar[XB_XGEN(b.x)], 1u);
      asm volatile("s_waitcnt vmcnt(0)" ::: "memory");
    } else {
      XB_SPIN(xb_ld(&bar[XB_XGEN(b.x)]) == gen, bar);
      __builtin_amdgcn_fence(__ATOMIC_ACQUIRE, "agent");
      asm volatile("s_waitcnt vmcnt(0)" ::: "memory");
    }
  }
  __syncthreads();
}

__global__ void __launch_bounds__(256, 2) mega(Params p_in, int ph_begin, int ph_end) {
  __shared__ __attribute__((aligned(16))) unsigned char smem[74752];
  __shared__ int s_item;
  __shared__ uint4 xb_words;
  if (ph_begin == 0x7fffffff) cg::this_grid().sync();
  int ph = 0;
  unsigned* xbar = (unsigned*)(p_in.ws + OFF_BAR);
  if (threadIdx.x == 0) xb_words = make_uint4(0u, 0u, 0u, 0u);
  __syncthreads();
  XcdBarrier gbar; gbar.bar = xbar; gbar.x = 0; gbar.st = (volatile LAS unsigned*)&xb_words;
#define PHASE_BEGIN { Params p = p_in; p.ws = launder(p.ws); p.out = launder(p.out); p.x = launder(p.x); \
    unsigned char* ws = p.ws; bf16_t* hb = (bf16_t*)(ws + OFF_HB); bf16_t* xb = (bf16_t*)(ws + OFF_XB); float* ssq = (float*)(ws + OFF_SSQ); \
    unsigned char* big = ws + OFF_BIG; unsigned* ctrs = (unsigned*)(ws + OFF_CTRL); \
    const float* cosT = (const float*)(ws + OFF_COS); const float* sinT = (const float*)(ws + OFF_SIN); const EvenBufs eb = even_bufs(big); \
    (void)hb; (void)xb; (void)ssq; (void)ctrs; (void)cosT; (void)sinT; (void)eb; \
    const int nrep = ((REPEAT_MASK >> ph) & 1ull) ? 2 : 1; for (int rep = 0; rep < nrep; ++rep) { if (rep) xcd_barrier(gbar);
#define PHASE_END  } xcd_barrier(gbar); } ++ph;

  gbar = xcd_barrier_post(xbar, (volatile LAS unsigned*)&xb_words);
  { Params p = p_in; p.ws = launder(p.ws); p.x = launder(p.x); prep_phase(p, smem); }
  xcd_barrier(gbar);
  ++ph;

  for (int layer = 0; layer < 4; ++layer) {
    const int e = layer >> 1;
    if ((layer & 1) == 0) {
      PHASE_BEGIN
        EpiEvenIn epi; epi.eb = eb; epi.cosT = cosT; epi.sinT = sinT;
        gemm_phase(xb, LDX, (const bf16_t*)(ws + OFF_WEI) + (size_t)e * EN * LDX, LDX, M, EN, 1024, ssq, epi, smem);
      PHASE_END
      PHASE_BEGIN
        unsigned* done = ctrs + 16 + layer + 8 * rep;
        const int pmq = rep ? PROBE_MODE : 0;
        for (;;) {
          const int idx = fetch_item(ctrs + layer + 8 * rep, &s_item);
          const int nconv = layer_conv_items(layer);
          if (idx >= 16 + nconv + 512) break;
          if (idx < 16) { if (pmq == 0 || pmq == 4) compress_item(p, eb, e, idx, done, smem); }
          else if (idx < 16 + nconv) { if (pmq == 0 || pmq == 5) ffn_conv_item(p, layer, idx - 16, smem); }
          else if (pmq == 0 || pmq == 3) { const int q = idx - 16 - nconv; diff_item(p, eb, e, (q >> 2) & 3, q & 3, 31 - (q >> 4), smem); }
        }
        if (pmq == 0 || pmq == 4) {
          wait_count(done, 16u);
          for (;;) {
            const int idx = fetch_item(ctrs + 32 + layer + 8 * rep, &s_item);
            if (idx >= 1024) break;
            nsa_item(p, eb, (idx >> 1) & 3, idx & 1, 127 - (idx >> 3), smem);
          }
        }
      PHASE_END
      PHASE_BEGIN
        EpiResid er; er.rin = layer == 0 ? p.x : p.out; er.out = p.out; er.xb = xb; er.ssq = ssq;
        gemm_phase(hb, LDX, (const bf16_t*)(ws + OFF_WEO) + (size_t)e * 1024 * LDX, LDX, M, 1024, 1024, nullptr, er, smem);
      PHASE_END
    } else {
      PHASE_BEGIN
        EpiOddIn epi; epi.Q = (bf16_t*)big; epi.K = (bf16_t*)(big + 32 * MiB); epi.VT = (bf16_t*)(big + 64 * MiB);
        gemm_phase(xb, LDX, (const bf16_t*)(ws + OFF_WOI) + (size_t)e * 3072 * LDX, LDX, M, 3072, 1024, ssq, epi, smem);
      PHASE_END
      PHASE_BEGIN
        for (;;) {
          const int idx = fetch_item(ctrs + layer + 8 * rep, &s_item);
          const int nconv = layer_conv_items(layer);
          if (idx >= nconv + 2048) break;
          if (idx < nconv) ffn_conv_item(p, layer, idx, smem);
          else { const int q = idx - nconv; sb_item(p, (q >> 4) & 3, q & 15, 31 - (q >> 6), smem); }
        }
      PHASE_END
      PHASE_BEGIN
        EpiResid er; er.rin = p.out; er.out = p.out; er.xb = xb; er.ssq = ssq;
        gemm_phase(hb, LDX, (const bf16_t*)(ws + OFF_WOO) + (size_t)e * 1024 * LDX, LDX, M, 1024, 1024, nullptr, er, smem);
      PHASE_END
    }
    PHASE_BEGIN
      EpiSwiGLU es; es.act = (bf16_t*)big;
      gemm_phase(xb, LDX, (const bf16_t*)(ws + OFF_WGU), LDX, M, 5632, 1024, ssq, es, smem, rep ? PROBE_MODE : 0);
    PHASE_END
    PHASE_BEGIN
      EpiResid er; er.rin = p.out; er.out = p.out; er.xb = xb; er.ssq = ssq;
      gemm_phase((const bf16_t*)big, LDF, (const bf16_t*)(ws + OFF_WDN), LDF, M, 1024, FH, nullptr, er, smem);
    PHASE_END
  }
  { Params p = p_in; p.out = launder(p.out); final_phase(p.out, p.norm_final); }
}

extern "C" void kernel_launch(void* const* d_in, const int* in_sizes, int n_in, void* d_out, int out_size, void* d_ws, size_t ws_size,
                              hipStream_t stream) {
  Params p; memset(&p, 0, sizeof(p));
  p.x = (const float*)d_in[0]; p.norm_mix = (const float*)d_in[1]; p.norm_ffn = (const float*)d_in[2]; p.norm_final = (const float*)d_in[3];
  p.even_w_in = (const float*)d_in[4]; p.even_w_out = (const float*)d_in[5]; p.cmp_pos_k = (const float*)d_in[6]; p.cmp_w_k = (const float*)d_in[7];
  p.cmp_pos_v = (const float*)d_in[8]; p.cmp_w_v = (const float*)d_in[9]; p.lq1 = (const float*)d_in[10]; p.lk1 = (const float*)d_in[11];
  p.lq2 = (const float*)d_in[12]; p.lk2 = (const float*)d_in[13]; p.subln = (const float*)d_in[14]; p.odd_w_in = (const float*)d_in[15];
  p.odd_w_out = (const float*)d_in[16]; p.w_gate = (const float*)d_in[17]; p.w_up = (const float*)d_in[18]; p.w_down = (const float*)d_in[19];
  p.out = (float*)d_out; p.ws = (unsigned char*)d_ws;
  static int grid_blocks = 0;
  if (!grid_blocks) {
    int dev = 0, cus = 0, per_cu = 0;
    (void)hipGetDevice(&dev);
    (void)hipDeviceGetAttribute(&cus, hipDeviceAttributeMultiprocessorCount, dev);
    (void)hipOccupancyMaxActiveBlocksPerMultiprocessor(&per_cu, mega, 256, 0);
    if (per_cu > 2) per_cu = 2;
    if (per_cu < 1) per_cu = 1;
    grid_blocks = cus * per_cu;
  }
  int pb = 0, pe = 1000;
  void* args[] = {&p, &pb, &pe};
  (void)hipMemsetAsync((unsigned char*)d_ws + OFF_CTRL, 0, 4096, stream);
  (void)hipMemsetAsync((unsigned char*)d_ws + OFF_BAR, 0, 16384, stream);
  hipError_t err = hipLaunchCooperativeKernel((void*)mega, dim3(grid_blocks), dim3(256), args, 0, stream);
  if (err != hipSuccess) fprintf(stderr, "cooperative launch failed: %s (grid %d)\n", hipGetErrorString(err), grid_blocks);
}
```

```cpp
#include <hip/hip_runtime.h>
#include <hip/hip_cooperative_groups.h>
#include <cstdio>
#include <cstring>
namespace cg = cooperative_groups;

#ifndef SB_EARLY
#define SB_EARLY 1
#endif
#ifndef PROBE_MODE
#define PROBE_MODE 0
#endif
#ifndef REPEAT_MASK
#define REPEAT_MASK 0ull
#endif

#define DI __device__ __forceinline__
typedef unsigned short bf16_t;
typedef unsigned long long u64;
typedef short bf16x8 __attribute__((ext_vector_type(8)));
typedef short bf16x4 __attribute__((ext_vector_type(4)));
typedef float f32x16 __attribute__((ext_vector_type(16)));
typedef float f32x4 __attribute__((ext_vector_type(4)));
typedef float f32x2 __attribute__((ext_vector_type(2)));
typedef unsigned u32x4 __attribute__((ext_vector_type(4)));
typedef unsigned u32x2 __attribute__((ext_vector_type(2)));
typedef __bf16 bf2_t __attribute__((ext_vector_type(2)));

DI unsigned pack2(float a, float b) { bf2_t v = __builtin_convertvector((f32x2){a, b}, bf2_t); return __builtin_bit_cast(unsigned, v); }
DI bf16_t tobf(float a) { return (bf16_t)(pack2(a, 0.f) & 0xffffu); }
#define MFMA(a, b, c) __builtin_amdgcn_mfma_f32_32x32x16_bf16((a), (b), (c), 0, 0, 0)
DI int crow(int i, int h) { return (i & 3) + 8 * (i >> 2) + 4 * h; }
DI float shx32(float v) { return __shfl_xor(v, 32); }
DI int otid() { int t = threadIdx.x; asm volatile("" : "+v"(t)); return t; }
template <class T> DI T* launder(T* q) { asm volatile("" : "+s"(q)); return q; }

constexpr int S = 4096, M = 16384, DM = 1024, FH = 2816, EN = 2944;
constexpr int LDX = 1088, LDF = 2880, SP = 4224;
constexpr float L2E = 1.4426950408889634f;
constexpr float NEG = -1e30f;

constexpr size_t MiB = 1048576;
constexpr size_t OFF_CTRL = 0;
constexpr size_t OFF_COS = 4096;
constexpr size_t OFF_SIN = OFF_COS + 524288;
constexpr size_t OFF_CBIAS = OFF_SIN + 524288;
constexpr size_t OFF_CPART = OFF_CBIAS + 4096;
constexpr size_t OFF_BAR = OFF_CPART + 32768;
constexpr size_t OFF_CMPW = OFF_BAR + 16384;
constexpr size_t OFF_WEI = OFF_CMPW + 2097152;
constexpr size_t OFF_WEO = OFF_WEI + (size_t)2 * EN * LDX * 2;
constexpr size_t OFF_WOI = OFF_WEO + (size_t)2 * 1024 * LDX * 2;
constexpr size_t OFF_WOO = OFF_WOI + (size_t)2 * 3072 * LDX * 2;
constexpr size_t OFF_WGU = OFF_WOO + (size_t)2 * 1024 * LDX * 2;
constexpr size_t OFF_WDN = OFF_WGU + (size_t)5632 * LDX * 2;
constexpr size_t OFF_SSQ = OFF_WDN + (size_t)1024 * LDF * 2;
constexpr size_t OFF_HB = OFF_SSQ + 1048576;
constexpr size_t OFF_XB = OFF_HB + (size_t)M * LDX * 2;
constexpr size_t OFF_BIG = OFF_XB + (size_t)M * LDX * 2;
static_assert(OFF_BIG + 98 * MiB < 250 * MiB, "workspace budget");

struct Params {
  const float *x, *norm_mix, *norm_ffn, *norm_final, *even_w_in, *even_w_out, *cmp_pos_k, *cmp_w_k, *cmp_pos_v, *cmp_w_v;
  const float *lq1, *lk1, *lq2, *lk2, *subln, *odd_w_in, *odd_w_out, *w_gate, *w_up, *w_down;
  float* out;
  unsigned char* ws;
};

struct EvenBufs { bf16_t *QN, *KC, *VC, *KS, *VST, *KW, *VWT, *DQ, *DK, *DVT, *KCMP, *VCMPT; float* gate; };
DI EvenBufs even_bufs(unsigned char* big) {
  constexpr size_t VSTB = (size_t)8 * 64 * SP * 2, DVTB = (size_t)16 * 128 * SP * 2;
  EvenBufs e; unsigned char* q = big;
  e.QN = (bf16_t*)q; q += 16 * MiB; e.KC = (bf16_t*)q; q += 4 * MiB; e.VC = (bf16_t*)q; q += 4 * MiB; e.KS = (bf16_t*)q; q += 4 * MiB;
  e.VST = (bf16_t*)q; q += VSTB; e.KW = (bf16_t*)q; q += 4 * MiB; e.VWT = (bf16_t*)q; q += VSTB; e.DQ = (bf16_t*)q; q += 16 * MiB;
  e.DK = (bf16_t*)q; q += 16 * MiB; e.DVT = (bf16_t*)q; q += DVTB; e.gate = (float*)q; q += 1572864;
  e.KCMP = (bf16_t*)q; q += 262144; e.VCMPT = (bf16_t*)q;
  return e;
}

template <int NV> struct TR_ { u32x4 v[NV]; };
typedef const __attribute__((address_space(1))) u32x4* gvec_t;
DI u32x4 gload16(const bf16_t* p) { return *(gvec_t)(unsigned long long)p; }
template <int NV> DI void tload(TR_<NV>& t, const bf16_t* g, size_t ld, int tid) {
#pragma unroll
  for (int i = 0; i < NV; ++i) t.v[i] = gload16(g + (size_t)((tid >> 3) + 32 * i) * ld + (tid & 7) * 8);
  __builtin_amdgcn_sched_barrier(0);
}
template <int NV> DI void tstore72(const TR_<NV>& t, bf16_t* s, int tid) {
#pragma unroll
  for (int i = 0; i < NV; ++i) *(u32x4*)(s + ((tid >> 3) + 32 * i) * 72 + (tid & 7) * 8) = t.v[i];
}
template <int NV> DI void tstore68(const TR_<NV>& t, bf16_t* s, int tid) {
#pragma unroll
  for (int i = 0; i < NV; ++i) {
    bf16_t* d = s + ((tid >> 3) + 32 * i) * 68 + (tid & 7) * 8;
    *(u32x2*)d = (u32x2){t.v[i].x, t.v[i].y};
    *(u32x2*)(d + 4) = (u32x2){t.v[i].z, t.v[i].w};
  }
}

constexpr int LDT = 40;
struct GRegs { u32x4 a[4], b[2]; };
DI void g_issue(GRegs& g, const bf16_t* Ag, size_t lda, const bf16_t* Bg, size_t ldb, unsigned offA, unsigned offB, int kt) {
#pragma unroll
  for (int i = 0; i < 4; ++i) g.a[i] = *(gvec_t)((unsigned long long)(Ag + (size_t)(64 * i) * lda + kt * 32) + offA);
#pragma unroll
  for (int i = 0; i < 2; ++i) g.b[i] = *(gvec_t)((unsigned long long)(Bg + (size_t)(64 * i) * ldb + kt * 32) + offB);
}
DI void g_write(const GRegs& g, bf16_t* cA, bf16_t* cB, int tid) {
  const int row = tid >> 2, pc = (tid & 3) ^ ((tid >> 4) & 3);
#pragma unroll
  for (int i = 0; i < 4; ++i) *(u32x4*)(cA + (row + 64 * i) * 32 + pc * 8) = g.a[i];
#pragma unroll
  for (int i = 0; i < 2; ++i) *(u32x4*)(cB + (row + 64 * i) * 32 + pc * 8) = g.b[i];
}
constexpr int STG_A = 8192, STG = 12288;
DI void dma_issue(const bf16_t* Ag, size_t lda, const bf16_t* Bg, size_t ldb, int kt, bf16_t* stage, int wid, int lane) {
  const int rl = lane >> 2, c = (lane & 3) ^ ((lane >> 4) & 3);
#pragma unroll
  for (int i = 0; i < 4; ++i) {
    const int j = wid + 4 * i;
    __builtin_amdgcn_global_load_lds((const unsigned*)(Ag + (size_t)(16 * j + rl) * lda + kt * 32 + c * 8), (unsigned*)(stage + j * 512), 16, 0, 0);
  }
#pragma unroll
  for (int i = 0; i < 2; ++i) {
    const int j = wid + 4 * i;
    __builtin_amdgcn_global_load_lds((const unsigned*)(Bg + (size_t)(16 * j + rl) * ldb + kt * 32 + c * 8), (unsigned*)(stage + STG_A + j * 512), 16, 0, 0);
  }
}
template <bool VT>
DI void g_compute(const bf16_t* cA, const bf16_t* cB, f32x16 (&acc)[4][2], int wm, int wn, int r, int h) {
  bf16x8 af[2][4], bfr[2][2];
#pragma unroll
  for (int s = 0; s < 2; ++s) {
#pragma unroll
    for (int ni = 0; ni < 2; ++ni) bfr[s][ni] = *(const bf16x8*)(cB + (wn * 64 + ni * 32 + r) * 32 + (((2 * s + h) ^ (r >> 2)) & 3) * 8);
#pragma unroll
    for (int mi = 0; mi < 4; ++mi) af[s][mi] = *(const bf16x8*)(cA + (wm * 128 + mi * 32 + r) * 32 + (((2 * s + h) ^ (r >> 2)) & 3) * 8);
  }
  __builtin_amdgcn_sched_barrier(0);
#pragma unroll
  for (int s = 0; s < 2; ++s)
#pragma unroll
    for (int mi = 0; mi < 4; ++mi)
#pragma unroll
      for (int ni = 0; ni < 2; ++ni) {
        if (VT) acc[mi][ni] = MFMA(af[s][mi], bfr[s][ni], acc[mi][ni]);
        else acc[mi][ni] = MFMA(bfr[s][ni], af[s][mi], acc[mi][ni]);
      }
}
#define DSR(dst, addr, off) asm volatile("ds_read_b128 %0, %1 offset:" #off : "=&v"(dst) : "v"(addr))
template <bool VT>
DI void g_compute_asm(unsigned aA0, unsigned aA1, unsigned aB0, unsigned aB1, f32x16 (&acc)[4][2]) {
  bf16x8 a0[4], a1[4], b0[2], b1[2];
  DSR(b0[0], aB0, 0); DSR(b0[1], aB0, 2048);
  DSR(a0[0], aA0, 0); DSR(a0[1], aA0, 2048); DSR(a0[2], aA0, 4096); DSR(a0[3], aA0, 6144);
  DSR(b1[0], aB1, 0); DSR(b1[1], aB1, 2048);
  DSR(a1[0], aA1, 0); DSR(a1[1], aA1, 2048); DSR(a1[2], aA1, 4096); DSR(a1[3], aA1, 6144);
  asm volatile("s_waitcnt lgkmcnt(6)" : "+v"(b0[0]), "+v"(b0[1]), "+v"(a0[0]), "+v"(a0[1]), "+v"(a0[2]), "+v"(a0[3]));
#pragma unroll
  for (int mi = 0; mi < 4; ++mi)
#pragma unroll
    for (int ni = 0; ni < 2; ++ni) {
      if (VT) acc[mi][ni] = MFMA(a0[mi], b0[ni], acc[mi][ni]);
      else acc[mi][ni] = MFMA(b0[ni], a0[mi], acc[mi][ni]);
    }
  __builtin_amdgcn_sched_barrier(0);
  asm volatile("s_waitcnt lgkmcnt(0)" : "+v"(b1[0]), "+v"(b1[1]), "+v"(a1[0]), "+v"(a1[1]), "+v"(a1[2]), "+v"(a1[3]));
#pragma unroll
  for (int mi = 0; mi < 4; ++mi)
#pragma unroll
    for (int ni = 0; ni < 2; ++ni) {
      if (VT) acc[mi][ni] = MFMA(a1[mi], b1[ni], acc[mi][ni]);
      else acc[mi][ni] = MFMA(b1[ni], a1[mi], acc[mi][ni]);
    }
}
template <bool VT>
DI int gemm_kloop(const bf16_t* Ag, size_t lda, const bf16_t* Bg, size_t ldb, int nk, bf16_t* ring, f32x16 (&acc)[4][2], int tid, int wm, int wn,
                  int r, int h, int st0, bool pre, const bf16_t* AgN, const bf16_t* BgN) {
  const int wid = tid >> 6, lane = tid & 63;
  const unsigned base = (unsigned)(unsigned long long)ring;
  const int q = (r >> 2) & 3;
  const unsigned rA = base + (unsigned)(wm * 128 + r) * 64u, rB = base + (unsigned)STG_A * 2u + (unsigned)(wn * 64 + r) * 64u;
  const unsigned oA0 = rA + (unsigned)((h ^ q) & 3) * 16u, oA1 = rA + (unsigned)(((2 + h) ^ q) & 3) * 16u;
  const unsigned oB0 = rB + (unsigned)((h ^ q) & 3) * 16u, oB1 = rB + (unsigned)(((2 + h) ^ q) & 3) * 16u;
  int st = st0;
  if (!pre) {
    dma_issue(Ag, lda, Bg, ldb, 0, ring + st * STG, wid, lane);
    dma_issue(Ag, lda, Bg, ldb, 1, ring + (st == 2 ? 0 : st + 1) * STG, wid, lane);
  }
  for (int kt = 0; kt < nk - 1; ++kt) {
    asm volatile("s_waitcnt vmcnt(6)" ::: "memory");
    __builtin_amdgcn_s_barrier();
    if (kt + 2 < nk) dma_issue(Ag, lda, Bg, ldb, kt + 2, ring + (st == 0 ? 2 : st - 1) * STG, wid, lane);
    const unsigned so = (unsigned)st * (unsigned)(STG * 2);
    g_compute_asm<VT>(oA0 + so, oA1 + so, oB0 + so, oB1 + so, acc);
    st = st == 2 ? 0 : st + 1;
  }
  asm volatile("s_waitcnt vmcnt(0)" ::: "memory");
  __builtin_amdgcn_s_barrier();
  if (AgN) {
    const int s1 = st == 2 ? 0 : st + 1, s2 = s1 == 2 ? 0 : s1 + 1;
    dma_issue(AgN, lda, BgN, ldb, 0, ring + s1 * STG, wid, lane);
    dma_issue(AgN, lda, BgN, ldb, 1, ring + s2 * STG, wid, lane);
  }
  {
    const unsigned so = (unsigned)st * (unsigned)(STG * 2);
    g_compute_asm<VT>(oA0 + so, oA1 + so, oB0 + so, oB1 + so, acc);
  }
  asm volatile("s_waitcnt lgkmcnt(0)" ::: "memory");
  return st;
}
template <bool VT>
DI void gemm_kloop_simple(const bf16_t* Ag, size_t lda, const bf16_t* Bg, size_t ldb, int nk, bf16_t* sA, bf16_t* sB, f32x16 (&acc)[4][2], int tid, int wm,
                          int wn, int r, int h) {
  GRegs g0;
  const unsigned offA = (unsigned)(((tid >> 2) * lda + (tid & 3) * 8) * 2), offB = (unsigned)(((tid >> 2) * ldb + (tid & 3) * 8) * 2);
  g_issue(g0, Ag, lda, Bg, ldb, offA, offB, 0);
  for (int kt = 0; kt < nk; ++kt) {
    bf16_t* cA = sA + (kt & 1) * STG;
    bf16_t* cB = cA + STG_A;
    g_write(g0, cA, cB, tid);
    __syncthreads();
    if (kt + 1 < nk) g_issue(g0, Ag, lda, Bg, ldb, offA, offB, kt + 1);
    __builtin_amdgcn_sched_barrier(0);
    g_compute<VT>(cA, cB, acc, wm, wn, r, h);
  }
}
template <bool DEEP, class Epi>
DI int gemm_tile(const bf16_t* __restrict__ A, int lda, const bf16_t* __restrict__ Bt, int ldb, int K, const float* ssq, int tm, int tn, const Epi& epi,
                 unsigned char* smem, int pm, int st0 = 0, bool pre = false, int tmN = -1, int tnN = 0) {
  const int tid = otid();
  const int lane = tid & 63, wid = tid >> 6, r = lane & 31, h = lane >> 5, wm = wid >> 1, wn = wid & 1;
  bf16_t* sA = (bf16_t*)smem;
  bf16_t* sB = sA;
  float* sR = (float*)(smem + 73728);
  const int m0 = tm << 8, n0 = tn << 7;
  const bf16_t* Ag = A + (size_t)m0 * lda;
  const bf16_t* Bg = Bt + (size_t)n0 * ldb;
  if (ssq) {
    const f32x4* sp = (const f32x4*)(ssq + (size_t)(m0 + tid) * 16);
    const f32x4 a = sp[0], b = sp[1], c = sp[2], d = sp[3];
    const float tot = ((a.x + a.y) + (a.z + a.w)) + ((b.x + b.y) + (b.z + b.w)) + ((c.x + c.y) + (c.z + c.w)) + ((d.x + d.y) + (d.z + d.w));
    sR[tid] = rsqrtf(tot * (1.f / DM) + 1e-6f);
  }
  __syncthreads();
  f32x16 acc[4][2];
#pragma unroll
  for (int a = 0; a < 4; ++a)
#pragma unroll
    for (int b = 0; b < 2; ++b)
#pragma unroll
      for (int i = 0; i < 16; ++i) acc[a][b][i] = 0.f;
  const bool vt = epi.vtype(n0 + wn * 64);
  int st_last = 0;
  if (pm == 2) K >>= 1;
  if (DEEP) {
    const bf16_t* AgN = tmN >= 0 ? A + (size_t)(tmN << 8) * lda : nullptr;
    const bf16_t* BgN = Bt + (size_t)(tnN << 7) * ldb;
    if (vt) st_last = gemm_kloop<true>(Ag, lda, Bg, ldb, K >> 5, sA, acc, tid, wm, wn, r, h, st0, pre, AgN, BgN);
    else st_last = gemm_kloop<false>(Ag, lda, Bg, ldb, K >> 5, sA, acc, tid, wm, wn, r, h, st0, pre, AgN, BgN);
  } else {
    if (vt) gemm_kloop_simple<true>(Ag, lda, Bg, ldb, K >> 5, sA, sB, acc, tid, wm, wn, r, h);
    else gemm_kloop_simple<false>(Ag, lda, Bg, ldb, K >> 5, sA, sB, acc, tid, wm, wn, r, h);
  }
  if (Epi::STAGED) __syncthreads();
  float* stg = Epi::CHAIN ? (float*)(smem + st_last * (STG * 2) + wid * 6144) : (float*)smem + wid * 2176;
  if (pm == 0) epi(acc, vt, m0 + wm * 128, n0 + wn * 64, r, h, sR + wm * 128, stg);
  __syncthreads();
  return st_last;
}
template <class Epi>
DI void gemm_phase(const bf16_t* __restrict__ A, int lda, const bf16_t* __restrict__ Bt, int ldb, int Mr, int N, int K, const float* ssq, const Epi& epi,
                   unsigned char* smem, int pm = 0) {
  const int tid = otid();
  const int nM = Mr >> 8, nN = (N + 127) >> 7, ntiles = nM * nN;
  const int band = nM >> 3;
  int st0 = 0; bool pre = false;
  for (int t = blockIdx.x; t < ntiles; t += gridDim.x) {
    const int xcd = t & 7, j = t >> 3;
    const int grp = j / (8 * nN), jj = j % (8 * nN);
    const int tm = xcd * band + grp * 8 + (jj & 7), tn = jj >> 3;
    int tmN = -1, tnN = 0;
    const int tN = t + (int)gridDim.x;
    if (Epi::CHAIN && tN < ntiles) {
      const int xN = tN & 7, jN = tN >> 3, gN = jN / (8 * nN), jjN = jN % (8 * nN);
      tmN = xN * band + gN * 8 + (jjN & 7); tnN = jjN >> 3;
    }
    const int stl = gemm_tile<true>(A, lda, Bt, ldb, K, ssq, tm, tn, epi, smem, pm, st0, pre, tmN, tnN);
    pre = tmN >= 0;
    st0 = stl == 2 ? 0 : stl + 1;
  }
}

DI u32x2 pack4(float a, float b, float c, float d) { u32x2 w; w.x = pack2(a, b); w.y = pack2(c, d); return w; }
DI void flush_rows(const bf16_t* st, bf16_t* dst, int lane) {
#pragma unroll
  for (int j = 0; j < 4; ++j) {
    const int rr = j * 8 + (lane >> 3), cc = (lane & 7) * 8;
    *(u32x4*)(dst + rr * 64 + cc) = *(const u32x4*)(st + rr * 72 + cc);
  }
}
DI void flush_tr(const bf16_t* st, bf16_t* dst, int lane) {
#pragma unroll
  for (int j = 0; j < 4; ++j) {
    const int dd = j * 16 + (lane >> 2), cc = (lane & 3) * 8;
    *(u32x4*)(dst + (size_t)dd * SP + cc) = *(const u32x4*)(st + dd * 40 + cc);
  }
}
struct EpiEvenIn {
  static constexpr bool STAGED = true, CHAIN = true;
  EvenBufs eb; const float* cosT; const float* sinT;
  DI bool vtype(int col0) const { const int seg = col0 >> 6; return seg == 14 || seg == 15 || seg == 18 || seg == 19 || (seg >= 36 && seg < 44); }
  DI void rope(const f32x16 (&acc)[4][2], int row0, int r, int h, const float* sR, bf16_t* dst, int H, int hh, float scale, bf16_t* st) const {
    const int lane = h * 32 + r, b = row0 >> 12, sb = row0 & 4095;
#pragma unroll
    for (int mi = 0; mi < 4; ++mi) {
      const int s = sb + mi * 32 + r;
      const float rv = sR[mi * 32 + r] * scale;
#pragma unroll
      for (int g = 0; g < 4; ++g) {
        const int d0 = 8 * g + 4 * h;
        const f32x4 c = *(const f32x4*)(cosT + s * 32 + d0), sn = *(const f32x4*)(sinT + s * 32 + d0);
        float o1[4], o2[4];
#pragma unroll
        for (int q = 0; q < 4; ++q) {
          const float x1 = acc[mi][0][4 * g + q] * rv, x2 = acc[mi][1][4 * g + q] * rv;
          o1[q] = x1 * c[q] - x2 * sn[q]; o2[q] = x1 * sn[q] + x2 * c[q];
        }
        *(u32x2*)(st + r * 72 + d0) = pack4(o1[0], o1[1], o1[2], o1[3]);
        *(u32x2*)(st + r * 72 + 32 + d0) = pack4(o2[0], o2[1], o2[2], o2[3]);
      }
      flush_rows(st, dst + ((size_t)(b * H + hh) * S + sb + mi * 32) * 64, lane);
    }
  }
  DI void rowmajor(const f32x16 (&acc)[4][2], int row0, int r, int h, const float* sR, bf16_t* dst, int H, int hh, float scale, bf16_t* st) const {
    const int lane = h * 32 + r, b = row0 >> 12, sb = row0 & 4095;
#pragma unroll
    for (int mi = 0; mi < 4; ++mi) {
      const float rv = sR[mi * 32 + r] * scale;
#pragma unroll
      for (int ni = 0; ni < 2; ++ni)
#pragma unroll
        for (int g = 0; g < 4; ++g)
          *(u32x2*)(st + r * 72 + ni * 32 + 8 * g + 4 * h) = pack4(acc[mi][ni][4 * g] * rv, acc[mi][ni][4 * g + 1] * rv, acc[mi][ni][4 * g + 2] * rv, acc[mi][ni][4 * g + 3] * rv);
      flush_rows(st, dst + ((size_t)(b * H + hh) * S + sb + mi * 32) * 64, lane);
    }
  }
  DI void transposed(const f32x16 (&acc)[4][2], int row0, int r, int h, const float* sR, bf16_t* dst, int H, int hh, bf16_t* st) const {
    const int lane = h * 32 + r, b = row0 >> 12, sb = row0 & 4095;
#pragma unroll
    for (int mi = 0; mi < 4; ++mi) {
#pragma unroll
      for (int g = 0; g < 4; ++g) {
        const f32x4 rv = *(const f32x4*)(sR + mi * 32 + 8 * g + 4 * h);
#pragma unroll
        for (int ni = 0; ni < 2; ++ni)
          *(u32x2*)(st + (ni * 32 + r) * 40 + 8 * g + 4 * h) =
              pack4(acc[mi][ni][4 * g] * rv.x, acc[mi][ni][4 * g + 1] * rv.y, acc[mi][ni][4 * g + 2] * rv.z, acc[mi][ni][4 * g + 3] * rv.w);
      }
      flush_tr(st, dst + (size_t)(b * H + hh) * 64 * SP + sb + mi * 32, lane);
    }
  }
  DI void operator()(const f32x16 (&acc)[4][2], bool vt, int row0, int col0, int r, int h, const float* sR, float* stage) const {
    const int seg = col0 >> 6;
    bf16_t* st = (bf16_t*)stage;
    if (seg < 8) rope(acc, row0, r, h, sR, eb.QN, 8, seg, 0.125f, st);
    else if (seg < 10) rope(acc, row0, r, h, sR, eb.KC, 2, seg - 8, 1.f, st);
    else if (seg < 12) rowmajor(acc, row0, r, h, sR, eb.VC, 2, seg - 10, 1.f, st);
    else if (seg < 14) rope(acc, row0, r, h, sR, eb.KS, 2, seg - 12, 1.f, st);
    else if (seg < 16) transposed(acc, row0, r, h, sR, eb.VST, 2, seg - 14, st);
    else if (seg < 18) rope(acc, row0, r, h, sR, eb.KW, 2, seg - 16, 1.f, st);
    else if (seg < 20) transposed(acc, row0, r, h, sR, eb.VWT, 2, seg - 18, st);
    else if (seg < 28) rope(acc, row0, r, h, sR, eb.DQ, 8, seg - 20, 0.125f, st);
    else if (seg < 36) rope(acc, row0, r, h, sR, eb.DK, 8, seg - 28, 1.f, st);
    else if (seg < 44) transposed(acc, row0, r, h, sR, eb.DVT, 8, seg - 36, st);
    else if (seg == 44) {
#pragma unroll
      for (int mi = 0; mi < 4; ++mi) {
        const int row = row0 + mi * 32 + r;
        const float rv = sR[mi * 32 + r];
#pragma unroll
        for (int g = 0; g < 3; ++g) {
          f32x4 o;
#pragma unroll
          for (int q = 0; q < 4; ++q) o[q] = 1.f / (1.f + __expf(-acc[mi][0][4 * g + q] * rv));
          *(f32x4*)(eb.gate + (size_t)row * 24 + 8 * g + 4 * h) = o;
        }
      }
    }
  }
};

struct EpiOddIn {
  static constexpr bool STAGED = true, CHAIN = true;
  bf16_t *Q, *K, *VT;
  DI bool vtype(int col0) const { return col0 >= 2048; }
  DI void operator()(const f32x16 (&acc)[4][2], bool vt, int row0, int col0, int r, int h, const float* sR, float* stage) const {
    const int seg = col0 >> 6, lane = h * 32 + r, b = row0 >> 12, sb = row0 & 4095;
    bf16_t* st = (bf16_t*)stage;
    if (seg < 32) {
      bf16_t* dst = seg < 16 ? Q : K; const int hh = seg & 15; const float sc = seg < 16 ? 0.125f : 1.f;
#pragma unroll
      for (int mi = 0; mi < 4; ++mi) {
        const float rv = sR[mi * 32 + r] * sc;
#pragma unroll
        for (int ni = 0; ni < 2; ++ni)
#pragma unroll
          for (int g = 0; g < 4; ++g)
            *(u32x2*)(st + r * 72 + ni * 32 + 8 * g + 4 * h) = pack4(acc[mi][ni][4 * g] * rv, acc[mi][ni][4 * g + 1] * rv, acc[mi][ni][4 * g + 2] * rv, acc[mi][ni][4 * g + 3] * rv);
        flush_rows(st, dst + ((size_t)(b * 16 + hh) * S + sb + mi * 32) * 64, lane);
      }
    } else {
      const int hh = seg - 32;
#pragma unroll
      for (int mi = 0; mi < 4; ++mi) {
#pragma unroll
        for (int g = 0; g < 4; ++g) {
          const f32x4 rv = *(const f32x4*)(sR + mi * 32 + 8 * g + 4 * h);
#pragma unroll
          for (int ni = 0; ni < 2; ++ni)
            *(u32x2*)(st + (ni * 32 + r) * 40 + 8 * g + 4 * h) =
                pack4(acc[mi][ni][4 * g] * rv.x, acc[mi][ni][4 * g + 1] * rv.y, acc[mi][ni][4 * g + 2] * rv.z, acc[mi][ni][4 * g + 3] * rv.w);
        }
        flush_tr(st, VT + (size_t)(b * 16 + hh) * 64 * SP + sb + mi * 32, lane);
      }
    }
  }
};

struct EpiResid {
  static constexpr bool STAGED = true, CHAIN = false;
  const float* rin; float* out; bf16_t* xb; float* ssq;
  DI bool vtype(int) const { return false; }
  DI void operator()(const f32x16 (&acc)[4][2], bool vt, int row0, int col0, int r, int h, const float* sR, float* stage) const {
    const int lane = h * 32 + r, lr = lane >> 4, lc = (lane & 15) * 4;
#pragma unroll
    for (int mi = 0; mi < 4; ++mi) {
#pragma unroll
      for (int ni = 0; ni < 2; ++ni)
#pragma unroll
        for (int g = 0; g < 4; ++g)
          *(f32x4*)(stage + r * 68 + ni * 32 + 8 * g + 4 * h) = (f32x4){acc[mi][ni][4 * g], acc[mi][ni][4 * g + 1], acc[mi][ni][4 * g + 2], acc[mi][ni][4 * g + 3]};
#pragma unroll
      for (int j = 0; j < 8; ++j) {
        const int rr = j * 4 + lr;
        f32x4 v = *(const f32x4*)(stage + rr * 68 + lc);
        const size_t row = row0 + mi * 32 + rr, idx = row * DM + col0 + lc;
        const f32x4 xin = *(const f32x4*)(rin + idx);
        v += xin;
        *(f32x4*)(out + idx) = v;
        *(u32x2*)(xb + row * LDX + col0 + lc) = pack4(v.x, v.y, v.z, v.w);
        float ss = (v.x * v.x + v.y * v.y) + (v.z * v.z + v.w * v.w);
        ss += __shfl_xor(ss, 1); ss += __shfl_xor(ss, 2); ss += __shfl_xor(ss, 4); ss += __shfl_xor(ss, 8);
        if ((lane & 15) == 0) ssq[row * 16 + (col0 >> 6)] = ss;
      }
    }
  }
};

struct EpiSwiGLU {
  static constexpr bool STAGED = true, CHAIN = true;
  bf16_t* act;
  DI bool vtype(int) const { return false; }
  DI void operator()(const f32x16 (&acc)[4][2], bool vt, int row0, int col0, int r, int h, const float* sR, float* stage) const {
    bf16_t* st = (bf16_t*)stage;
    const int lane = h * 32 + r;
#pragma unroll
    for (int mi = 0; mi < 4; ++mi) {
      const float rv = sR[mi * 32 + r];
#pragma unroll
      for (int g = 0; g < 4; ++g) {
        float o[4];
#pragma unroll
        for (int q = 0; q < 4; ++q) {
          const float gt = acc[mi][0][4 * g + q] * rv, up = acc[mi][1][4 * g + q] * rv;
          o[q] = gt * __builtin_amdgcn_rcpf(1.f + __expf(-gt)) * up;
        }
        *(u32x2*)(st + r * 40 + 8 * g + 4 * h) = pack4(o[0], o[1], o[2], o[3]);
      }
#pragma unroll
      for (int j = 0; j < 2; ++j) {
        const int rr = j * 16 + (lane >> 2), cc = (lane & 3) * 8;
        const u32x4 v = *(const u32x4*)(st + rr * 40 + cc);
        *(u32x4*)(act + (size_t)(row0 + mi * 32 + rr) * LDF + (col0 >> 1) + cc) = v;
      }
    }
  }
};

struct EpiCompress {
  static constexpr bool STAGED = false, CHAIN = false;
  bf16_t* dst; const float* sBias; int tr;
  DI bool vtype(int) const { return tr != 0; }
  DI void operator()(const f32x16 (&acc)[4][2], bool vt, int row0, int col0, int r, int h, const float*, float*) const {
    if (col0 != 0) return;
#pragma unroll
    for (int mi = 0; mi < 4; ++mi) {
      if (tr) {
#pragma unroll
        for (int g = 0; g < 4; ++g) {
          const int R = row0 + mi * 32 + 8 * g + 4 * h, bg = R >> 8, n = R & 255;
#pragma unroll
          for (int ni = 0; ni < 2; ++ni) {
            const float bv = sBias[ni * 32 + r];
            float v[4];
#pragma unroll
            for (int q = 0; q < 4; ++q) v[q] = (n + q == 255) ? 0.f : acc[mi][ni][4 * g + q] + bv;
            *(u32x2*)(dst + ((size_t)bg * 64 + ni * 32 + r) * 256 + n) = pack4(v[0], v[1], v[2], v[3]);
          }
        }
      } else {
        const int R = row0 + mi * 32 + r, bg = R >> 8, n = R & 255;
#pragma unroll
        for (int ni = 0; ni < 2; ++ni)
#pragma unroll
          for (int g = 0; g < 4; ++g) {
            const int d0 = ni * 32 + 8 * g + 4 * h;
            float v[4];
#pragma unroll
            for (int q = 0; q < 4; ++q) v[q] = (n == 255) ? 0.f : acc[mi][ni][4 * g + q] + sBias[d0 + q];
            *(u32x2*)(dst + ((size_t)bg * 256 + n) * 64 + d0) = pack4(v[0], v[1], v[2], v[3]);
          }
      }
    }
  }
};

DI void qk_tile(const bf16_t* sK, const bf16x8 (&qf)[4], f32x16 (&Sx)[2], int r, int h) {
#pragma unroll
  for (int mt = 0; mt < 2; ++mt) {
    f32x16 a;
#pragma unroll
    for (int i = 0; i < 16; ++i) a[i] = 0.f;
#pragma unroll
    for (int s = 0; s < 4; ++s) {
      const bf16x8 k = *(const bf16x8*)(sK + (mt * 32 + r) * 72 + s * 16 + h * 8);
      a = MFMA(k, qf[s], a);
    }
    Sx[mt] = a;
  }
}
template <int NDT> DI void pv_tile(const bf16_t* sV, const f32x16 (&P)[2], f32x16 (&O)[NDT], int r, int h) {
#pragma unroll
  for (int mt = 0; mt < 2; ++mt)
#pragma unroll
    for (int sp = 0; sp < 2; ++sp) {
      u32x4 pk;
      pk.x = pack2(P[mt][8 * sp + 0], P[mt][8 * sp + 1]); pk.y = pack2(P[mt][8 * sp + 2], P[mt][8 * sp + 3]);
      pk.z = pack2(P[mt][8 * sp + 4], P[mt][8 * sp + 5]); pk.w = pack2(P[mt][8 * sp + 6], P[mt][8 * sp + 7]);
      const bf16x8 pb = __builtin_bit_cast(bf16x8, pk);
#pragma unroll
      for (int dt = 0; dt < NDT; ++dt) {
        const bf16_t* vp = sV + (dt * 32 + r) * 68 + mt * 32 + sp * 16 + 4 * h;
        const bf16x4 lo = *(const bf16x4*)vp, hi = *(const bf16x4*)(vp + 8);
        const bf16x8 va = __builtin_shufflevector(lo, hi, 0, 1, 2, 3, 4, 5, 6, 7);
        O[dt] = MFMA(va, pb, O[dt]);
      }
      if (NDT > 2) __builtin_amdgcn_sched_barrier(0);
    }
}
template <bool MASKED>
DI float online_softmax_t(f32x16 (&Sx)[2], unsigned vb, float& m, float& l) {
  float mx = NEG;
#pragma unroll
  for (int mt = 0; mt < 2; ++mt)
#pragma unroll
    for (int i = 0; i < 16; ++i) {
      float s = Sx[mt][i];
      if (MASKED) { s = ((vb >> (mt * 16 + i)) & 1u) ? s : NEG; Sx[mt][i] = s; }
      mx = fmaxf(mx, s);
    }
  mx = fmaxf(mx, shx32(mx));
  const float mn = fmaxf(m, mx);
  const float alpha = __builtin_amdgcn_exp2f((m - mn) * L2E);
  const float mb = mn * L2E;
  f32x2 sum2 = {0.f, 0.f};
  const f32x2 l2e2 = {L2E, L2E}, mb2 = {mb, mb};
#pragma unroll
  for (int mt = 0; mt < 2; ++mt)
#pragma unroll
    for (int i = 0; i < 16; i += 2) {
      const f32x2 t = (f32x2){Sx[mt][i], Sx[mt][i + 1]} * l2e2 - mb2;
      f32x2 p = {__builtin_amdgcn_exp2f(t.x), __builtin_amdgcn_exp2f(t.y)};
      if (MASKED) { p.x = ((vb >> (mt * 16 + i)) & 1u) ? p.x : 0.f; p.y = ((vb >> (mt * 16 + i + 1)) & 1u) ? p.y : 0.f; }
      Sx[mt][i] = p.x; Sx[mt][i + 1] = p.y;
      sum2 += p;
    }
  l = l * alpha + (sum2.x + sum2.y);
  m = mn;
  return alpha;
}
DI float online_softmax(f32x16 (&Sx)[2], unsigned vb, bool masked, float& m, float& l) {
  float alpha;
  if (masked) alpha = online_softmax_t<true>(Sx, vb, m, l);
  else { __builtin_amdgcn_sched_barrier(0); alpha = online_softmax_t<false>(Sx, vb, m, l); __builtin_amdgcn_sched_barrier(0); }
  return alpha;
}
template <int NDT> DI void scale_o(f32x16 (&O)[NDT], float a) {
#pragma unroll
  for (int dt = 0; dt < NDT; ++dt)
#pragma unroll
    for (int i = 0; i < 16; ++i) O[dt][i] *= a;
}
template <int NDT> DI void zero_o(f32x16 (&O)[NDT]) {
#pragma unroll
  for (int dt = 0; dt < NDT; ++dt)
#pragma unroll
    for (int i = 0; i < 16; ++i) O[dt][i] = 0.f;
}
DI void load_q(bf16x8 (&qf)[4], const bf16_t* qrow, int h) {
#pragma unroll
  for (int s = 0; s < 4; ++s) qf[s] = *(const bf16x8*)(qrow + s * 16 + h * 8);
}

DI void diff_pass(const bf16_t* Qrow, const bf16_t* Kg, const bf16_t* VTg, int qt, int q0, int t, f32x16 (&O)[4], float& lsum,
                  bf16_t* sK, bf16_t* sV, int tid, int r, int h) {
  bf16x8 qf[4]; load_q(qf, Qrow, h);
  const int kt_hi = 2 * qt + 1, my_hi = (q0 + 31) >> 6;
  float m = NEG, l = 0.f;
  zero_o<4>(O);
  TR_<2> kr; TR_<4> vr;
  tload(kr, Kg, 64, tid); tload(vr, VTg, SP, tid);
  for (int kt = 0; kt <= kt_hi; ++kt) {
    __syncthreads();
    tstore72(kr, sK, tid); tstore68(vr, sV, tid);
    __syncthreads();
    if (kt < kt_hi) { tload(kr, Kg + (size_t)(kt + 1) * 64 * 64, 64, tid); tload(vr, VTg + (kt + 1) * 64, SP, tid); }
    if (kt <= my_hi) {
      f32x16 Sx[2];
      qk_tile(sK, qf, Sx, r, h);
      const bool masked = (kt * 64 + 63 > q0);
      unsigned vb = 0;
      if (masked) {
#pragma unroll
        for (int mt = 0; mt < 2; ++mt)
#pragma unroll
          for (int i = 0; i < 16; ++i) vb |= (unsigned)(kt * 64 + mt * 32 + crow(i, h) <= t) << (mt * 16 + i);
      }
      const float alpha = online_softmax(Sx, vb, masked, m, l);
      scale_o<4>(O, alpha);
      pv_tile<4>(sV, Sx, O, r, h);
    }
  }
  lsum = l + shx32(l);
}

DI void diff_item(const Params& p_, const EvenBufs& eb_, int e, int b, int hh, int qt, unsigned char* smem) {
  Params p = p_; p.ws = launder(p.ws); p.subln = launder(p.subln);
  const EvenBufs eb = even_bufs(p.ws + OFF_BIG);
  const int tid = otid(), lane = tid & 63, wid = tid >> 6, r = lane & 31, h = lane >> 5;
  bf16_t* sK = (bf16_t*)smem; bf16_t* sV = sK + 64 * 72;
  const int q0 = qt * 128 + wid * 32, t = q0 + r;
  const bf16_t* VTg = eb.DVT + (size_t)(b * 4 + hh) * 128 * SP;
  f32x16 O[4]; float l1, l2;
  diff_pass(eb.DQ + ((size_t)(b * 8 + hh * 2) * S + t) * 64, eb.DK + (size_t)(b * 8 + hh * 2) * S * 64, VTg, qt, q0, t, O, l1, sK, sV, tid, r, h);
  unsigned* o1s = (unsigned*)(smem + 40960) + tid;
  {
    const float inv = 1.f / l1;
#pragma unroll
    for (int dt = 0; dt < 4; ++dt)
#pragma unroll
      for (int i = 0; i < 8; ++i) o1s[(dt * 8 + i) * 256] = pack2(O[dt][2 * i] * inv, O[dt][2 * i + 1] * inv);
  }
  diff_pass(eb.DQ + ((size_t)(b * 8 + hh * 2 + 1) * S + t) * 64, eb.DK + (size_t)(b * 8 + hh * 2 + 1) * S * 64, VTg, qt, q0, t, O, l2, sK, sV, tid, r, h);
  int e2 = e; asm volatile("" : "+s"(e2));
  const float lam = ((const float*)(p.ws + OFF_CBIAS + 2048))[e2];
  const float lam_init = 0.8f - 0.6f * __expf(-0.3f * (float)(2 * e2));
  const float c2 = lam / l2;
  float ss = 0.f;
#pragma unroll
  for (int dt = 0; dt < 4; ++dt)
#pragma unroll
    for (int i = 0; i < 8; ++i) {
      const unsigned ov = o1s[(dt * 8 + i) * 256];
      const float a0 = __uint_as_float(ov << 16), a1 = __uint_as_float(ov & 0xffff0000u);
      const float v0 = a0 - c2 * O[dt][2 * i], v1 = a1 - c2 * O[dt][2 * i + 1];
      O[dt][2 * i] = v0; O[dt][2 * i + 1] = v1;
      ss += v0 * v0 + v1 * v1;
    }
  ss += shx32(ss);
  const float rinv = rsqrtf(ss * (1.f / 128.f) + 1e-6f) * (1.f - lam_init);
  const float* sub = p.subln + e * 128;
  bf16_t* orow = (bf16_t*)(p.ws + OFF_HB) + (size_t)(b * S + t) * LDX + 512 + hh * 128;
#pragma unroll
  for (int dt = 0; dt < 4; ++dt)
#pragma unroll
    for (int g = 0; g < 4; ++g) {
      __builtin_amdgcn_sched_barrier(0);
      const int d = dt * 32 + 8 * g + 4 * h;
      const f32x4 sg = *(const f32x4*)(sub + d);
      u32x2 w;
      w.x = pack2(O[dt][4 * g] * rinv * sg.x, O[dt][4 * g + 1] * rinv * sg.y);
      w.y = pack2(O[dt][4 * g + 2] * rinv * sg.z, O[dt][4 * g + 3] * rinv * sg.w);
      *(u32x2*)(orow + d) = w;
    }
}

DI void nsa_item(const Params& p_, const EvenBufs& eb_, int b, int g, int tt, unsigned char* smem) {
  Params p = p_; p.ws = launder(p.ws);
  const EvenBufs eb = even_bufs(p.ws + OFF_BIG);
  const int tid = otid(), lane = tid & 63, wid = tid >> 6, r = lane & 31, h = lane >> 5;
  bf16_t* sK = (bf16_t*)smem; bf16_t* sV = sK + 64 * 72;
  float* impW = (float*)(smem + 18432);
  u64* selm = (u64*)(smem + 18432 + 32768);
  const int t0 = tt * 32, t = t0 + r, head = g * 4 + wid, bg = b * 2 + g;
  bf16x8 qf[4]; load_q(qf, eb.QN + ((size_t)(b * 8 + head) * S + t) * 64, h);
  const float* gp = eb.gate + (size_t)(b * S + t) * 24 + head * 3;
  const float g0 = gp[0], g1 = gp[1], g2 = gp[2];
  f32x16 acc[2], O[2];

  const int nct = (t0 >> 10) + 1, nlim = (t - 31) >> 4;
  const bf16_t* Kc = eb.KCMP + (size_t)bg * 256 * 64;
  const bf16_t* VcT = eb.VCMPT + (size_t)bg * 64 * 256;
  float m = NEG, l = 0.f;
  for (int kt = 0; kt < nct; ++kt) {
    TR_<2> kr; tload(kr, Kc + kt * 64 * 64, 64, tid);
    __syncthreads();
    tstore72(kr, sK, tid);
    __syncthreads();
    f32x16 Sx[2]; qk_tile(sK, qf, Sx, r, h);
    unsigned vb = 0;
#pragma unroll
    for (int mt = 0; mt < 2; ++mt)
#pragma unroll
      for (int i = 0; i < 16; ++i) vb |= (unsigned)(kt * 64 + mt * 32 + crow(i, h) <= nlim) << (mt * 16 + i);
    online_softmax_t<true>(Sx, vb, m, l);
  }
  l += shx32(l);
  const float invl = l > 0.f ? 1.f / l : 0.f;
  const float mb = m * L2E;
  zero_o<2>(O);
  float carry_prev = 0.f;
  for (int kt = 0; kt < nct; ++kt) {
    TR_<2> kr, vr; tload(kr, Kc + kt * 64 * 64, 64, tid); tload(vr, VcT + kt * 64, 256, tid);
    __syncthreads();
    tstore72(kr, sK, tid); tstore68(vr, sV, tid);
    __syncthreads();
    f32x16 Sx[2]; qk_tile(sK, qf, Sx, r, h);
#pragma unroll
    for (int mt = 0; mt < 2; ++mt) {
#pragma unroll
      for (int i = 0; i < 16; ++i) {
        const bool ok = (kt * 64 + mt * 32 + crow(i, h)) <= nlim;
        const float pr = __builtin_amdgcn_exp2f(Sx[mt][i] * L2E - mb) * invl;
        Sx[mt][i] = ok ? pr : 0.f;
      }
      float x[4];
#pragma unroll
      for (int gg = 0; gg < 4; ++gg) x[gg] = shx32(Sx[mt][4 * gg + 3]);
#pragma unroll
      for (int gg = 0; gg < 4; ++gg) {
        const float prev = h ? x[gg] : (gg ? x[gg > 0 ? gg - 1 : 0] : carry_prev);
        const float val = Sx[mt][4 * gg] + Sx[mt][4 * gg + 1] + Sx[mt][4 * gg + 2] + Sx[mt][4 * gg + 3] + prev;
        impW[(wid * 32 + r) * 64 + kt * 16 + mt * 8 + 2 * gg + h] = val;
      }
      carry_prev = x[3];
    }
    pv_tile<2>(sV, Sx, O, r, h);
  }
#pragma unroll
  for (int dt = 0; dt < 2; ++dt)
#pragma unroll
    for (int i = 0; i < 16; ++i) acc[dt][i] = g0 * O[dt][i];
  __syncthreads();
  for (int q = 0; q < 8; ++q) {
    const int rr = wid * 8 + q, tq = t0 + rr, qb = tq >> 6;
    float v = 0.f;
    if (lane < nct * 16) v = impW[(0 * 32 + rr) * 64 + lane] + impW[(1 * 32 + rr) * 64 + lane] + impW[(2 * 32 + rr) * 64 + lane] + impW[(3 * 32 + rr) * 64 + lane];
    const bool forced = (lane == 0) || (lane == qb) || (lane == qb - 1);
    v = forced ? 1e30f : ((lane > qb) ? -1e30f : v);
    int rank = 0;
#pragma unroll
    for (int jj = 0; jj < 64; ++jj) {
      const float o = __builtin_bit_cast(float, __builtin_amdgcn_readlane(__builtin_bit_cast(int, v), jj));
      rank += ((o > v) || (o == v && jj < lane)) ? 1 : 0;
    }
    const bool sel = (rank < 16) && (v >= 0.f);
    const u64 mk = __ballot(sel);
    if (lane == 0) selm[rr] = mk;
  }
  __syncthreads();
  const u64 mysel = selm[r];
  u64 un;
  {
    unsigned lo = (unsigned)mysel, hi = (unsigned)(mysel >> 32);
#pragma unroll
    for (int o = 1; o < 32; o <<= 1) { lo |= (unsigned)__shfl_xor((int)lo, o); hi |= (unsigned)__shfl_xor((int)hi, o); }
    un = ((u64)hi << 32) | lo;
    un = ((u64)(unsigned)__builtin_amdgcn_readfirstlane((int)hi) << 32) | (unsigned)__builtin_amdgcn_readfirstlane((int)lo);
  }
  {
    const bf16_t* Kg = eb.KS + (size_t)bg * S * 64;
    const bf16_t* VTg = eb.VST + (size_t)bg * 64 * SP;
    m = NEG; l = 0.f; zero_o<2>(O);
    u64 rem = un;
    int j = __builtin_ctzll(rem); rem &= rem - 1;
    TR_<2> kr, vr; tload(kr, Kg + (size_t)j * 64 * 64, 64, tid); tload(vr, VTg + j * 64, SP, tid);
    while (true) {
      __syncthreads();
      tstore72(kr, sK, tid); tstore68(vr, sV, tid);
      __syncthreads();
      int jn = -1;
      if (rem) { jn = __builtin_ctzll(rem); rem &= rem - 1; tload(kr, Kg + (size_t)jn * 64 * 64, 64, tid); tload(vr, VTg + jn * 64, SP, tid); }
      f32x16 Sx[2]; qk_tile(sK, qf, Sx, r, h);
      const bool sb = (mysel >> j) & 1ull;
      unsigned vb = sb ? 0xffffffffu : 0u;
      bool masked = (__ballot(sb) != ~0ull);
      if (j == (t0 >> 6)) {
        masked = true; vb = 0;
#pragma unroll
        for (int mt = 0; mt < 2; ++mt)
#pragma unroll
          for (int i = 0; i < 16; ++i) vb |= (unsigned)(sb && (j * 64 + mt * 32 + crow(i, h) <= t)) << (mt * 16 + i);
      }
      if (!masked) vb = 0xffffffffu;
      const float alpha = online_softmax_t<true>(Sx, vb, m, l);
      scale_o<2>(O, alpha);
      pv_tile<2>(sV, Sx, O, r, h);
      if (jn < 0) break;
      j = jn;
    }
    l += shx32(l);
    const float c = g1 / l;
#pragma unroll
    for (int dt = 0; dt < 2; ++dt)
#pragma unroll
      for (int i = 0; i < 16; ++i) acc[dt][i] += c * O[dt][i];
  }
  {
    const bf16_t* Kg = eb.KW + (size_t)bg * S * 64;
    const bf16_t* VTg = eb.VWT + (size_t)bg * 64 * SP;
    m = NEG; l = 0.f; zero_o<2>(O);
    const int lo0 = t0 - 511;
    const int kt_lo = (lo0 > 0 ? lo0 : 0) >> 6, kt_hi = t0 >> 6;
    TR_<2> kr, vr; tload(kr, Kg + (size_t)kt_lo * 64 * 64, 64, tid); tload(vr, VTg + kt_lo * 64, SP, tid);
    for (int kt = kt_lo; kt <= kt_hi; ++kt) {
      __syncthreads();
      tstore72(kr, sK, tid); tstore68(vr, sV, tid);
      __syncthreads();
      if (kt < kt_hi) { tload(kr, Kg + (size_t)(kt + 1) * 64 * 64, 64, tid); tload(vr, VTg + (kt + 1) * 64, SP, tid); }
      f32x16 Sx[2]; qk_tile(sK, qf, Sx, r, h);
      const bool masked = !((kt * 64 + 63 <= t0) && (kt * 64 > t0 + 31 - 512));
      unsigned vb = 0;
      if (masked) {
#pragma unroll
        for (int mt = 0; mt < 2; ++mt)
#pragma unroll
          for (int i = 0; i < 16; ++i) {
            const int key = kt * 64 + mt * 32 + crow(i, h);
            vb |= (unsigned)((key <= t) && (key > t - 512)) << (mt * 16 + i);
          }
      }
      if (!masked) vb = 0xffffffffu;
      const float alpha = online_softmax_t<true>(Sx, vb, m, l);
      scale_o<2>(O, alpha);
      pv_tile<2>(sV, Sx, O, r, h);
    }
    l += shx32(l);
    const float c = g2 / l;
#pragma unroll
    for (int dt = 0; dt < 2; ++dt)
#pragma unroll
      for (int i = 0; i < 16; ++i) acc[dt][i] += c * O[dt][i];
  }
  bf16_t* orow = (bf16_t*)(p.ws + OFF_HB) + (size_t)(b * S + t) * LDX + head * 64;
#pragma unroll
  for (int dt = 0; dt < 2; ++dt)
#pragma unroll
    for (int gg = 0; gg < 4; ++gg) {
      u32x2 w; w.x = pack2(acc[dt][4 * gg], acc[dt][4 * gg + 1]); w.y = pack2(acc[dt][4 * gg + 2], acc[dt][4 * gg + 3]);
      *(u32x2*)(orow + dt * 32 + 8 * gg + 4 * h) = w;
    }
}

template <bool MASKED>
DI void sb_weights(f32x16 (&Sx)[2], float& carry, int kt, int t, int h) {
#pragma unroll
      for (int mt = 1; mt >= 0; --mt) {
        float L[16];
#pragma unroll
        for (int i = 0; i < 16; ++i) {
          const float z = Sx[mt][i];
          const bool ok = !MASKED || (kt * 64 + mt * 32 + crow(i, h) < t);
          const float sp = fmaxf(z, 0.f) + __logf(1.f + __expf(-fabsf(z)));
          L[i] = ok ? -sp : 0.f;
          Sx[mt][i] = ok ? (z - sp) : NEG;
        }
        float G[4], Go[4];
#pragma unroll
        for (int gg = 0; gg < 4; ++gg) { G[gg] = (L[4 * gg] + L[4 * gg + 1]) + (L[4 * gg + 2] + L[4 * gg + 3]); Go[gg] = shx32(G[gg]); }
        float T[4];
        T[3] = 0.f; T[2] = G[3] + Go[3]; T[1] = T[2] + (G[2] + Go[2]); T[0] = T[1] + (G[1] + Go[1]);
        const float tot = T[0] + (G[0] + Go[0]);
#pragma unroll
        for (int gg = 0; gg < 4; ++gg) {
          const float s3 = carry + T[gg] + (h ? 0.f : Go[gg]);
          const float s2 = s3 + L[4 * gg + 3], s1 = s2 + L[4 * gg + 2], s0 = s1 + L[4 * gg + 1];
          Sx[mt][4 * gg + 3] = __expf(Sx[mt][4 * gg + 3] + s3);
          Sx[mt][4 * gg + 2] = __expf(Sx[mt][4 * gg + 2] + s2);
          Sx[mt][4 * gg + 1] = __expf(Sx[mt][4 * gg + 1] + s1);
          Sx[mt][4 * gg + 0] = __expf(Sx[mt][4 * gg + 0] + s0);
        }
        carry += tot;
      }
}

DI void sb_item(const Params& p_, int b, int hh, int qt, unsigned char* smem) {
  Params p = p_; p.ws = launder(p.ws);
  const int tid = otid(), lane = tid & 63, wid = tid >> 6, r = lane & 31, h = lane >> 5;
  bf16_t* sK = (bf16_t*)smem; bf16_t* sV = sK + 64 * 72;
  unsigned char* big = p.ws + OFF_BIG;
  const bf16_t* Qb = (const bf16_t*)big; const bf16_t* Kb = (const bf16_t*)(big + 32 * MiB); const bf16_t* VTb = (const bf16_t*)(big + 64 * MiB);
  const int q0 = qt * 128 + wid * 32, t = q0 + r;
  bf16x8 qf[4]; load_q(qf, Qb + ((size_t)(b * 16 + hh) * S + t) * 64, h);
  const bf16_t* Kg = Kb + (size_t)(b * 16 + hh) * S * 64;
  const bf16_t* VTg = VTb + (size_t)(b * 16 + hh) * 64 * SP;
  const int kt_hi = 2 * qt + 1, my_hi = (q0 + 31) >> 6;
  f32x16 O[2]; zero_o<2>(O);
  float carry = 0.f;
  TR_<2> kr, vr; tload(kr, Kg + (size_t)kt_hi * 64 * 64, 64, tid); tload(vr, VTg + kt_hi * 64, SP, tid);
  __syncthreads();
  for (int kt = kt_hi; kt >= 0; --kt) {
    tstore72(kr, sK, tid); tstore68(vr, sV, tid);
    __syncthreads();
    if (kt > 0) { tload(kr, Kg + (size_t)(kt - 1) * 64 * 64, 64, tid); tload(vr, VTg + (kt - 1) * 64, SP, tid); }
    if (kt <= my_hi) {
      f32x16 Sx[2]; qk_tile(sK, qf, Sx, r, h);
      if (kt * 64 + 63 >= q0) sb_weights<true>(Sx, carry, kt, t, h);
      else { __builtin_amdgcn_sched_barrier(0); sb_weights<false>(Sx, carry, kt, t, h); __builtin_amdgcn_sched_barrier(0); }
      pv_tile<2>(sV, Sx, O, r, h);
    }
#if SB_EARLY
    {
      volatile int* flg = (volatile int*)(smem + 18432) + (kt & 1) * 4;
      const bool wall = (__ballot(carry < -104.f) == ~0ull);
      if (lane == 0) flg[wid] = wall ? 1 : 0;
      __syncthreads();
      if (flg[0] & flg[1] & flg[2] & flg[3]) break;
    }
#else
    __syncthreads();
#endif
  }
  bf16_t* orow = (bf16_t*)(p.ws + OFF_HB) + (size_t)(b * S + t) * LDX + hh * 64;
#pragma unroll
  for (int dt = 0; dt < 2; ++dt)
#pragma unroll
    for (int gg = 0; gg < 4; ++gg) {
      u32x2 w; w.x = pack2(O[dt][4 * gg], O[dt][4 * gg + 1]); w.y = pack2(O[dt][4 * gg + 2], O[dt][4 * gg + 3]);
      *(u32x2*)(orow + dt * 32 + 8 * gg + 4 * h) = w;
    }
}

DI void final_phase(float* xio, const float* g) {
  const int tidx = otid(), lane = tidx & 63, gw = blockIdx.x * 4 + (tidx >> 6), nw = gridDim.x * 4;
  for (int row = gw; row < M; row += nw) {
    float* xr = xio + (size_t)row * DM;
    f32x4 v[4]; float ss = 0.f;
#pragma unroll
    for (int i = 0; i < 4; ++i) { v[i] = *(const f32x4*)(xr + (i * 64 + lane) * 4); ss += v[i].x * v[i].x + v[i].y * v[i].y + v[i].z * v[i].z + v[i].w * v[i].w; }
#pragma unroll
    for (int o = 1; o < 64; o <<= 1) ss += __shfl_xor(ss, o);
    const float rinv = rsqrtf(ss * (1.f / DM) + 1e-6f);
#pragma unroll
    for (int i = 0; i < 4; ++i) {
      const f32x4 gg = *(const f32x4*)(g + (i * 64 + lane) * 4);
      f32x4 o; o.x = v[i].x * rinv * gg.x; o.y = v[i].y * rinv * gg.y; o.z = v[i].z * rinv * gg.z; o.w = v[i].w * rinv * gg.w;
      *(f32x4*)(xr + (i * 64 + lane) * 4) = o;
    }
  }
}
DI void xprep_phase(const float* xin, bf16_t* xb, float* ssq) {
  const int tidx = otid(), lane = tidx & 63, gw = blockIdx.x * 4 + (tidx >> 6), nw = gridDim.x * 4;
  for (int row = gw; row < M; row += nw) {
    const float* xr = xin + (size_t)row * DM;
    f32x4 v[4]; float ss = 0.f;
#pragma unroll
    for (int i = 0; i < 4; ++i) { v[i] = *(const f32x4*)(xr + (i * 64 + lane) * 4); ss += v[i].x * v[i].x + v[i].y * v[i].y + v[i].z * v[i].z + v[i].w * v[i].w; }
#pragma unroll
    for (int o = 1; o < 64; o <<= 1) ss += __shfl_xor(ss, o);
#pragma unroll
    for (int i = 0; i < 4; ++i) *(u32x2*)(xb + (size_t)row * LDX + (i * 64 + lane) * 4) = pack4(v[i].x, v[i].y, v[i].z, v[i].w);
    if (lane < 16) ssq[(size_t)row * 16 + lane] = lane == 0 ? ss : 0.f;
  }
}

struct TJob { const float* src; bf16_t* dst; const float* ks; int K, N, mode, ldd; };
DI TJob get_job(const Params& p, int j) {
  TJob t; t.ks = nullptr; t.ldd = LDX;
  unsigned char* ws = p.ws;
  if (j < 2) { t.src = p.even_w_in + (size_t)j * 1024 * 2840; t.dst = (bf16_t*)(ws + OFF_WEI) + (size_t)j * EN * LDX; t.K = 1024; t.N = 2840; t.mode = 1; t.ks = p.norm_mix + (2 * j) * DM; }
  else if (j < 4) { int e = j - 2; t.src = p.even_w_out + (size_t)e * 1024 * 1024; t.dst = (bf16_t*)(ws + OFF_WEO) + (size_t)e * 1024 * LDX; t.K = 1024; t.N = 1024; t.mode = 0; }
  else if (j < 6) { int e = j - 4; t.src = p.odd_w_in + (size_t)e * 1024 * 3072; t.dst = (bf16_t*)(ws + OFF_WOI) + (size_t)e * 3072 * LDX; t.K = 1024; t.N = 3072; t.mode = 0; t.ks = p.norm_mix + (2 * e + 1) * DM; }
  else if (j < 8) { int e = j - 6; t.src = p.odd_w_out + (size_t)e * 1024 * 1024; t.dst = (bf16_t*)(ws + OFF_WOO) + (size_t)e * 1024 * LDX; t.K = 1024; t.N = 1024; t.mode = 0; }
  else if (j < 10) { int e = j - 8; t.src = p.cmp_w_k + (size_t)e * 2048 * 64; t.dst = (bf16_t*)(ws + OFF_CMPW) + (size_t)(e * 2 + 0) * 128 * 2048; t.K = 2048; t.N = 64; t.mode = 0; t.ldd = 2048; }
  else { int e = j - 10; t.src = p.cmp_w_v + (size_t)e * 2048 * 64; t.dst = (bf16_t*)(ws + OFF_CMPW) + (size_t)(e * 2 + 1) * 128 * 2048; t.K = 2048; t.N = 64; t.mode = 0; t.ldd = 2048; }
  return t;
}
DI TJob ffn_job(const Params& p, int layer, int j) {
  TJob t; t.ks = nullptr; t.ldd = LDX;
  if (j == 0) { t.src = p.w_gate + (size_t)layer * 1024 * FH; t.dst = (bf16_t*)(p.ws + OFF_WGU); t.K = 1024; t.N = FH; t.mode = 2; t.ks = p.norm_ffn + layer * DM; }
  else if (j == 1) { t.src = p.w_up + (size_t)layer * 1024 * FH; t.dst = (bf16_t*)(p.ws + OFF_WGU); t.K = 1024; t.N = FH; t.mode = 3; t.ks = p.norm_ffn + layer * DM; }
  else { t.src = p.w_down + (size_t)layer * FH * 1024; t.dst = (bf16_t*)(p.ws + OFF_WDN); t.K = FH; t.N = 1024; t.mode = 0; t.ldd = LDF; }
  return t;
}
DI TJob layer_job(const Params& p, int layer, int j) {
  if (j < 3) return ffn_job(p, layer, j);
  if (j == 3) return get_job(p, (layer & 1) ? 6 + (layer >> 1) : 2 + (layer >> 1));
  return get_job(p, (layer & 1) ? 1 : 4 + (layer >> 1));
}
DI int layer_job_tiles(int layer, int j) { return j < 3 ? 704 : (j == 3 ? 256 : ((layer & 1) ? 720 : 768)); }
DI int layer_conv_items(int layer) { return layer == 3 ? 296 : ((layer & 1) ? 386 : 392); }
DI int map_col(int n, int mode) {
  if (mode == 0) return n;
  if (mode == 1) return n < 1280 ? n : (n < 1304 ? 2816 + (n - 1280) : n - 24);
  if (mode == 2) return (n >> 5) * 64 + (n & 31);
  return (n >> 5) * 64 + 32 + (n & 31);
}
DI void transpose_tile(const TJob& t, int lt, unsigned char* smem, int tid) {
  float* tl = (float*)smem;
  const int nkt = t.K >> 6, k0 = (lt % nkt) << 6, n0 = (lt / nkt) << 6;
  f32x4 v[4];
#pragma unroll
  for (int i = 0; i < 4; ++i) {
    const int k = i * 16 + (tid >> 4), n = (tid & 15) * 4;
    v[i] = (n0 + n < t.N) ? *(const f32x4*)(t.src + (size_t)(k0 + k) * t.N + n0 + n) : (f32x4){0.f, 0.f, 0.f, 0.f};
  }
#pragma unroll
  for (int i = 0; i < 4; ++i) {
    const int k = i * 16 + (tid >> 4), n = (tid & 15) * 4;
    const float sc = t.ks ? t.ks[k0 + k] : 1.f;
    tl[k * 65 + n] = v[i].x * sc; tl[k * 65 + n + 1] = v[i].y * sc; tl[k * 65 + n + 2] = v[i].z * sc; tl[k * 65 + n + 3] = v[i].w * sc;
  }
  __syncthreads();
#pragma unroll
  for (int i = 0; i < 8; ++i) {
    const int n = i * 8 + (tid >> 5), k2 = (tid & 31) * 2;
    if (n0 + n < t.N) *(unsigned*)(t.dst + (size_t)map_col(n0 + n, t.mode) * t.ldd + k0 + k2) = pack2(tl[k2 * 65 + n], tl[(k2 + 1) * 65 + n]);
  }
  __syncthreads();
}
DI void prep_phase(const Params& p, unsigned char* smem) {
  const int tid = otid();
  for (int tile = blockIdx.x; tile < 720 + 4 * 32; tile += gridDim.x) {
    const int j = tile < 720 ? 0 : 8 + (tile - 720) / 32, lt = tile < 720 ? tile : (tile - 720) % 32;
    const TJob t = get_job(p, j);
    transpose_tile(t, lt, smem, tid);
  }
  {
    const int gt = blockIdx.x * 256 + tid, nt = gridDim.x * 256;
    for (int i = gt; i < 2 * 104 * (LDX / 2); i += nt) {
      const int e = i / (104 * (LDX / 2)), rem = i % (104 * (LDX / 2));
      ((unsigned*)((bf16_t*)(p.ws + OFF_WEI) + (size_t)e * EN * LDX + (size_t)2840 * LDX))[rem] = 0u;
    }
    float* cosT = (float*)(p.ws + OFF_COS); float* sinT = (float*)(p.ws + OFF_SIN);
    for (int i = gt; i < S * 32; i += nt) {
      const int s = i >> 5, d = i & 31;
      const float inv = 1.0f / powf(10000.0f, (float)(2 * d) / 64.0f);
      const float ang = (float)s * inv;
      cosT[i] = cosf(ang); sinT[i] = sinf(ang);
    }
  }
  const int nb = gridDim.x;
  for (int jc = blockIdx.x; jc < 128; jc += nb) {
    const int j = jc >> 5, c = jc & 31, e = j >> 1, kv = j & 1, w = tid >> 6, d = tid & 63;
    const float* pos = (kv ? p.cmp_pos_v : p.cmp_pos_k) + (size_t)e * 2048 + c * 64 + w * 16;
    const float* wt = (kv ? p.cmp_w_v : p.cmp_w_k) + ((size_t)e * 2048 + c * 64 + w * 16) * 64 + d;
    float s = 0.f;
#pragma unroll
    for (int k = 0; k < 16; ++k) s += pos[k] * wt[(size_t)k * 64];
    float* red = (float*)smem;
    __syncthreads();
    red[tid] = s;
    __syncthreads();
    if (tid < 64) ((float*)(p.ws + OFF_CPART))[(j * 32 + c) * 64 + tid] = (red[tid] + red[64 + tid]) + (red[128 + tid] + red[192 + tid]);
  }
  if (blockIdx.x == (128 % nb) && tid < 2) {
    const int e = tid;
    float s1 = 0.f, s2 = 0.f;
    for (int k = 0; k < 64; ++k) { s1 += p.lq1[e * 64 + k] * p.lk1[e * 64 + k]; s2 += p.lq2[e * 64 + k] * p.lk2[e * 64 + k]; }
    const float lam_init = 0.8f - 0.6f * expf(-0.3f * (float)(2 * e));
    ((float*)(p.ws + OFF_CBIAS + 2048))[e] = expf(s1) - expf(s2) + lam_init;
  }
  xprep_phase(p.x, (bf16_t*)(p.ws + OFF_XB), (float*)(p.ws + OFF_SSQ));
}

DI int fetch_item(unsigned* ctr, int* s_item) {
  __syncthreads();
  if (threadIdx.x == 0) *s_item = (int)atomicAdd(ctr, 1u);
  __syncthreads();
  return *s_item;
}
DI void ffn_conv_item(const Params& p_, int layer, int it, unsigned char* smem) {
  Params p = p_; p.ws = launder(p.ws); p.w_gate = launder(p.w_gate); p.w_up = launder(p.w_up); p.w_down = launder(p.w_down); p.norm_ffn = launder(p.norm_ffn);
  p.even_w_in = launder(p.even_w_in); p.even_w_out = launder(p.even_w_out); p.odd_w_in = launder(p.odd_w_in); p.odd_w_out = launder(p.odd_w_out); p.norm_mix = launder(p.norm_mix);
  const int tid = otid();
  for (int q = 0; q < 8; ++q) {
    int lt = it * 8 + q, j = 0;
    while (lt >= layer_job_tiles(layer, j)) { lt -= layer_job_tiles(layer, j); ++j; }
    const TJob t = layer_job(p, layer, j);
    transpose_tile(t, lt, smem, tid);
  }
}
DI void compress_item(const Params& p_, const EvenBufs& eb_, int e, int it, unsigned* done, unsigned char* smem) {
  const int tid = otid();
  Params p = p_; p.ws = launder(p.ws);
  const EvenBufs eb = even_bufs(p.ws + OFF_BIG);
  const int kv = it >> 3, tm = it & 7;
  float* sBias = (float*)(smem + 73728);
  if (tid < 64) {
    const float* part = (const float*)(p.ws + OFF_CPART) + (size_t)(e * 2 + kv) * 32 * 64 + tid;
    float s = 0.f;
    for (int c = 0; c < 32; ++c) s += part[c * 64];
    sBias[tid] = s;
  }
  __syncthreads();
  EpiCompress ep; ep.dst = kv ? eb.VCMPT : eb.KCMP; ep.sBias = sBias; ep.tr = kv;
  gemm_tile<true>(kv ? eb.VC : eb.KC, 1024, (const bf16_t*)(p.ws + OFF_CMPW) + (size_t)(e * 2 + kv) * 128 * 2048, 2048, 2048, nullptr, tm, 0, ep, smem, 0);
  asm volatile("s_waitcnt vmcnt(0)" ::: "memory");
  __syncthreads();
  if (tid == 0) __hip_atomic_fetch_add(done, 1u, __ATOMIC_RELEASE, __HIP_MEMORY_SCOPE_AGENT);
}
DI void wait_count(unsigned* ctr, unsigned target) {
  if (threadIdx.x == 0) {
    while (__hip_atomic_load(ctr, __ATOMIC_RELAXED, __HIP_MEMORY_SCOPE_AGENT) < target) __builtin_amdgcn_s_sleep(8);
    __builtin_amdgcn_fence(__ATOMIC_ACQUIRE, "agent");
    asm volatile("s_waitcnt vmcnt(0)" ::: "memory");
  }
  __syncthreads();
}


#define XB_TMO      128
#define XB_XCNT(j)  (256  + 64 * (j))
#define XB_XSUB(j)  (1280 + 64 * (j))
#define XB_XGEN(j)  (2304 + 64 * (j))
#define XB_TOP      3328
#define XB_TOPGEN   3392
#define XCD_BAR_WORDS 3456
#define XB_SPIN_CAP (1u << 18)
#define LAS __attribute__((address_space(3)))
DI unsigned xb_ld(unsigned* p) { return __hip_atomic_load(p, __ATOMIC_RELAXED, __HIP_MEMORY_SCOPE_AGENT); }
DI unsigned xb_add(unsigned* p, unsigned v) { return __hip_atomic_fetch_add(p, v, __ATOMIC_RELAXED, __HIP_MEMORY_SCOPE_AGENT); }
DI unsigned xb_xcc_id() { return (unsigned)__builtin_amdgcn_s_getreg((3 << 11) | 20) & 0xFu; }
#define XB_SPIN(cond, bar) do { unsigned _sp = 0; while (cond) { __builtin_amdgcn_s_sleep(1); \
    if ((++_sp & 255u) == 0u) { if (xb_ld(&(bar)[XB_TMO])) break; if (_sp > XB_SPIN_CAP) { atomicAdd(&(bar)[XB_TMO], 1u); break; } } } } while (0)
struct XcdBarrier { unsigned* bar; unsigned x; volatile LAS unsigned* st; };
DI XcdBarrier xcd_barrier_post(unsigned* bar, volatile LAS unsigned* st) {
  XcdBarrier b; b.bar = bar; b.x = xb_xcc_id(); b.st = st;
  if (threadIdx.x == 0) (void)xb_add(&bar[XB_XCNT(b.x)], 1u);
  return b;
}
DI void xcd_barrier_complete(unsigned* bar, unsigned x, unsigned& nloc, unsigned& nx) {
  const unsigned G = gridDim.x * gridDim.y * gridDim.z;
  unsigned sum, cnt, mine, sp = 0u;
  for (;;) {
    sum = 0u; cnt = 0u; mine = 0u;
#pragma unroll
    for (unsigned j = 0; j < 16; ++j) { const unsigned c = xb_ld(&bar[XB_XCNT(j)]); sum += c; cnt += (c > 0u) ? 1u : 0u; mine = (j == x) ? c : mine; }
    if (sum == G) break;
    __builtin_amdgcn_s_sleep(1);
    if ((++sp & 255u) == 0u) { if (xb_ld(&bar[XB_TMO])) break; if (sp > XB_SPIN_CAP) { atomicAdd(&bar[XB_TMO], 1u); break; } }
  }
  nloc = mine > 0u ? mine : 1u; nx = cnt > 0u ? cnt : 1u;
}
DI void xcd_barrier(const XcdBarrier& b_) {
  XcdBarrier b = b_; b.x = xb_xcc_id(); b.bar = launder(b.bar);
  asm volatile("s_waitcnt vmcnt(0)" ::: "memory");
  __syncthreads();
  if (threadIdx.x == 0) {
    unsigned* bar = b.bar;
    __builtin_amdgcn_s_waitcnt(0);
    unsigned nloc = b.st[0], nx = b.st[1];
    if (nloc == 0u) { xcd_barrier_complete(bar, b.x, nloc, nx); b.st[0] = nloc; b.st[1] = nx; }
    const unsigned old = xb_add(&bar[XB_XSUB(b.x)], 1u);
    const unsigned gen = old / nloc;
    if (old + 1u == (gen + 1u) * nloc) {
      __builtin_amdgcn_fence(__ATOMIC_RELEASE, "agent");
      asm volatile("s_waitcnt vmcnt(0)" ::: "memory");
      const unsigned og = xb_add(&bar[XB_TOP], 1u);
      const unsigned tg = og / nx;
      if (og + 1u == (tg + 1u) * nx) xb_add(&bar[XB_TOPGEN], 1u);
      else XB_SPIN(xb_ld(&bar[XB_TOPGEN]) == tg, bar);
      __builtin_amdgcn_fence(__ATOMIC_ACQUIRE, "agent");
      xb_add(&bar[XB_XGEN(b.x)], 1u);
      asm volatile("s_waitcnt vmcnt(0)" ::: "memory");
    } else {
      XB_SPIN(xb_ld(&bar[XB_XGEN(b.x)]) == gen, bar);
      __builtin_amdgcn_fence(__ATOMIC_ACQUIRE, "agent");
      asm volatile("s_waitcnt vmcnt(0)" ::: "memory");
    }
  }
  __syncthreads();
}

__global__ void __launch_bounds__(256, 2) mega(Params p_in, int ph_begin, int ph_end) {
  __shared__ __attribute__((aligned(16))) unsigned char smem[74752];
  __shared__ int s_item;
  __shared__ uint4 xb_words;
  if (ph_begin == 0x7fffffff) cg::this_grid().sync();
  int ph = 0;
  unsigned* xbar = (unsigned*)(p_in.ws + OFF_BAR);
  if (threadIdx.x == 0) xb_words = make_uint4(0u, 0u, 0u, 0u);
  __syncthreads();
  XcdBarrier gbar; gbar.bar = xbar; gbar.x = 0; gbar.st = (volatile LAS unsigned*)&xb_words;
#define PHASE_BEGIN { Params p = p_in; p.ws = launder(p.ws); p.out = launder(p.out); p.x = launder(p.x); \
    unsigned char* ws = p.ws; bf16_t* hb = (bf16_t*)(ws + OFF_HB); bf16_t* xb = (bf16_t*)(ws + OFF_XB); float* ssq = (float*)(ws + OFF_SSQ); \
    unsigned char* big = ws + OFF_BIG; unsigned* ctrs = (unsigned*)(ws + OFF_CTRL); \
    const float* cosT = (const float*)(ws + OFF_COS); const float* sinT = (const float*)(ws + OFF_SIN); const EvenBufs eb = even_bufs(big); \
    (void)hb; (void)xb; (void)ssq; (void)ctrs; (void)cosT; (void)sinT; (void)eb; \
    const int nrep = ((REPEAT_MASK >> ph) & 1ull) ? 2 : 1; for (int rep = 0; rep < nrep; ++rep) { if (rep) xcd_barrier(gbar);
#define PHASE_END  } xcd_barrier(gbar); } ++ph;

  gbar = xcd_barrier_post(xbar, (volatile LAS unsigned*)&xb_words);
  { Params p = p_in; p.ws = launder(p.ws); p.x = launder(p.x); prep_phase(p, smem); }
  xcd_barrier(gbar);
  ++ph;

  for (int layer = 0; layer < 4; ++layer) {
    const int e = layer >> 1;
    if ((layer & 1) == 0) {
      PHASE_BEGIN
        EpiEvenIn epi; epi.eb = eb; epi.cosT = cosT; epi.sinT = sinT;
        gemm_phase(xb, LDX, (const bf16_t*)(ws + OFF_WEI) + (size_t)e * EN * LDX, LDX, M, EN, 1024, ssq, epi, smem);
      PHASE_END
      PHASE_BEGIN
        unsigned* done = ctrs + 16 + layer + 8 * rep;
        const int pmq = rep ? PROBE_MODE : 0;
        for (;;) {
          const int idx = fetch_item(ctrs + layer + 8 * rep, &s_item);
          const int nconv = layer_conv_items(layer);
          if (idx >= 16 + nconv + 512) break;
          if (idx < 16) { if (pmq == 0 || pmq == 4) compress_item(p, eb, e, idx, done, smem); }
          else if (idx < 16 + nconv) { if (pmq == 0 || pmq == 5) ffn_conv_item(p, layer, idx - 16, smem); }
          else if (pmq == 0 || pmq == 3) { const int q = idx - 16 - nconv; diff_item(p, eb, e, (q >> 2) & 3, q & 3, 31 - (q >> 4), smem); }
        }
        if (pmq == 0 || pmq == 4) {
          wait_count(done, 16u);
          for (;;) {
            const int idx = fetch_item(ctrs + 32 + layer + 8 * rep, &s_item);
            if (idx >= 1024) break;
            nsa_item(p, eb, (idx >> 1) & 3, idx & 1, 127 - (idx >> 3), smem);
          }
        }
      PHASE_END
      PHASE_BEGIN
        EpiResid er; er.rin = layer == 0 ? p.x : p.out; er.out = p.out; er.xb = xb; er.ssq = ssq;
        gemm_phase(hb, LDX, (const bf16_t*)(ws + OFF_WEO) + (size_t)e * 1024 * LDX, LDX, M, 1024, 1024, nullptr, er, smem);
      PHASE_END
    } else {
      PHASE_BEGIN
        EpiOddIn epi; epi.Q = (bf16_t*)big; epi.K = (bf16_t*)(big + 32 * MiB); epi.VT = (bf16_t*)(big + 64 * MiB);
        gemm_phase(xb, LDX, (const bf16_t*)(ws + OFF_WOI) + (size_t)e * 3072 * LDX, LDX, M, 3072, 1024, ssq, epi, smem);
      PHASE_END
      PHASE_BEGIN
        for (;;) {
          const int idx = fetch_item(ctrs + layer + 8 * rep, &s_item);
          const int nconv = layer_conv_items(layer);
          if (idx >= nconv + 2048) break;
          if (idx < nconv) ffn_conv_item(p, layer, idx, smem);
          else { const int q = idx - nconv; sb_item(p, (q >> 4) & 3, q & 15, 31 - (q >> 6), smem); }
        }
      PHASE_END
      PHASE_BEGIN
        EpiResid er; er.rin = p.out; er.out = p.out; er.xb = xb; er.ssq = ssq;
        gemm_phase(hb, LDX, (const bf16_t*)(ws + OFF_WOO) + (size_t)e * 1024 * LDX, LDX, M, 1024, 1024, nullptr, er, smem);
      PHASE_END
    }
    PHASE_BEGIN
      EpiSwiGLU es; es.act = (bf16_t*)big;
      gemm_phase(xb, LDX, (const bf16_t*)(ws + OFF_WGU), LDX, M, 5632, 1024, ssq, es, smem, rep ? PROBE_MODE : 0);
    PHASE_END
    PHASE_BEGIN
      EpiResid er; er.rin = p.out; er.out = p.out; er.xb = xb; er.ssq = ssq;
      gemm_phase((const bf16_t*)big, LDF, (const bf16_t*)(ws + OFF_WDN), LDF, M, 1024, FH, nullptr, er, smem);
    PHASE_END
  }
  { Params p = p_in; p.out = launder(p.out); final_phase(p.out, p.norm_final); }
}

extern "C" void kernel_launch(void* const* d_in, const int* in_sizes, int n_in, void* d_out, int out_size, void* d_ws, size_t ws_size,
                              hipStream_t stream) {
  Params p; memset(&p, 0, sizeof(p));
  p.x = (const float*)d_in[0]; p.norm_mix = (const float*)d_in[1]; p.norm_ffn = (const float*)d_in[2]; p.norm_final = (const float*)d_in[3];
  p.even_w_in = (const float*)d_in[4]; p.even_w_out = (const float*)d_in[5]; p.cmp_pos_k = (const float*)d_in[6]; p.cmp_w_k = (const float*)d_in[7];
  p.cmp_pos_v = (const float*)d_in[8]; p.cmp_w_v = (const float*)d_in[9]; p.lq1 = (const float*)d_in[10]; p.lk1 = (const float*)d_in[11];
  p.lq2 = (const float*)d_in[12]; p.lk2 = (const float*)d_in[13]; p.subln = (const float*)d_in[14]; p.odd_w_in = (const float*)d_in[15];
  p.odd_w_out = (const float*)d_in[16]; p.w_gate = (const float*)d_in[17]; p.w_up = (const float*)d_in[18]; p.w_down = (const float*)d_in[19];
  p.out = (float*)d_out; p.ws = (unsigned char*)d_ws;
  static int grid_blocks = 0;
  if (!grid_blocks) {
    int dev = 0, cus = 0, per_cu = 0;
    (void)hipGetDevice(&dev);
    (void)hipDeviceGetAttribute(&cus, hipDeviceAttributeMultiprocessorCount, dev);
    (void)hipOccupancyMaxActiveBlocksPerMultiprocessor(&per_cu, mega, 256, 0);
    if (per_cu > 2) per_cu = 2;
    if (per_cu < 1) per_cu = 1;
    grid_blocks = cus * per_cu;
  }
  int pb = 0, pe = 1000;
  void* args[] = {&p, &pb, &pe};
  (void)hipMemsetAsync((unsigned char*)d_ws + OFF_CTRL, 0, 4096, stream);
  (void)hipMemsetAsync((unsigned char*)d_ws + OFF_BAR, 0, 16384, stream);
  hipError_t err = hipLaunchCooperativeKernel((void*)mega, dim3(grid_blocks), dim3(256), args, 0, stream);
  if (err != hipSuccess) fprintf(stderr, "cooperative launch failed: %s (grid %d)\n", hipGetErrorString(err), grid_blocks);
}
```
